# Optimizing an MI355X kernel written in HIP

```python
import math
import jax, jax.numpy as jnp
from jax import lax
import numpy as np

D_MODEL = 1024
BATCH = 16
SEQ = 2048
DEPTH = 2

CTX_LEN = 256
GRID_W = 64
D_MIX = 1024
EPS = 1e-6
ROPE_BASE = 10000.0
Q_BLOCK = 128

MLA_HEADS = 6
MLA_NOPE = 64
MLA_ROPE = 32
MLA_V = 64
MLA_Q_RANK = 384
MLA_KV_RANK = 256
MLA_WIDTH = MLA_HEADS * MLA_V
MLA_SCALE = (MLA_NOPE + MLA_ROPE) ** -0.5

GQA_HEADS = 6
GQA_KV_HEADS = 2
GQA_GROUP = GQA_HEADS // GQA_KV_HEADS
GQA_DIM = 64
GQA_WIDTH = GQA_HEADS * GQA_DIM
GQA_SCALE = GQA_DIM ** -0.5

GDN_HEADS = 4
GDN_DK = 64
GDN_DV = 64
GDN_WIDTH = GDN_HEADS * GDN_DV
GDN_CONV = 5
GDN_CHUNK = 64

IN_SPLITS = (
    MLA_Q_RANK,
    MLA_KV_RANK,
    MLA_ROPE,
    GQA_HEADS * GQA_DIM,
    GQA_KV_HEADS * GQA_DIM,
    GQA_KV_HEADS * GQA_DIM,
    3 * GDN_HEADS * GDN_DK,
    2 * GDN_HEADS,
    2 * GDN_HEADS,
    D_MIX,
)
D_IN = sum(IN_SPLITS)

kernel_name = 'hybrid_mla_gqa_gdn_dit_block'


def rms_norm(x, g):
    xf = x.astype(jnp.float32)
    y = xf * lax.rsqrt(jnp.mean(xf * xf, axis=-1, keepdims=True) + EPS)
    return (y * g.astype(jnp.float32)).astype(x.dtype)


def l2norm(x):
    return x * lax.rsqrt(jnp.sum(x * x, axis=-1, keepdims=True) + EPS)


def split_cols(h):
    parts, start = [], 0
    for n in IN_SPLITS:
        parts.append(h[..., start:start + n])
        start += n
    return parts


def rope_1d(x, pos):
    d = x.shape[-1]
    half = d // 2
    inv = ROPE_BASE ** (-jnp.arange(0, d, 2, dtype=jnp.float32) / d)
    ang = pos.astype(jnp.float32)[:, None] * inv[None, :]
    shape = (pos.shape[0],) + (1,) * (x.ndim - 3) + (half,)
    cos, sin = jnp.cos(ang).reshape(shape), jnp.sin(ang).reshape(shape)
    xf = x.astype(jnp.float32)
    x1, x2 = xf[..., :half], xf[..., half:]
    return jnp.concatenate([x1 * cos - x2 * sin, x2 * cos + x1 * sin], -1).astype(x.dtype)


def rope_2d(x, rows, cols):
    h = x.shape[-1] // 2
    return jnp.concatenate([rope_1d(x[..., :h], rows), rope_1d(x[..., h:], cols)], -1)


def attend(q, k, v, scale):
    B, Lq, Hk, G, dq = q.shape
    nb = Lq // Q_BLOCK
    qb = jnp.moveaxis(q.reshape(B, nb, Q_BLOCK, Hk, G, dq), 1, 0)

    def one_block(qi):
        s = jnp.einsum('bqhgd,bkhd->bhgqk', qi, k).astype(jnp.float32) * scale
        p = jax.nn.softmax(s, axis=-1).astype(v.dtype)
        return jnp.einsum('bhgqk,bkhe->bqhge', p, v)

    o = lax.map(one_block, qb)
    return jnp.moveaxis(o, 0, 1).reshape(B, Lq, Hk * G * v.shape[-1])


def mla_q(cq, qn_g, w_uq, pos):
    B, L, _ = cq.shape
    q = (rms_norm(cq, qn_g) @ w_uq).reshape(B, L, MLA_HEADS, MLA_NOPE + MLA_ROPE)
    q_nope, q_rope = q[..., :MLA_NOPE], q[..., MLA_NOPE:]
    if pos is not None:
        q_rope = rope_2d(q_rope, *pos)
    return jnp.concatenate([q_nope, q_rope], -1)[:, :, :, None, :]


def mla_kv(ckv, kr, kvn_g, w_ukv, pos):
    B, L, _ = ckv.shape
    kv = (rms_norm(ckv, kvn_g) @ w_ukv).reshape(B, L, MLA_HEADS, MLA_NOPE + MLA_V)
    k_nope, v = kv[..., :MLA_NOPE], kv[..., MLA_NOPE:]
    kr = kr[:, :, None, :]
    if pos is not None:
        kr = rope_2d(kr, *pos)
    k = jnp.concatenate([k_nope, jnp.broadcast_to(kr, (B, L, MLA_HEADS, MLA_ROPE))], -1)
    return k, v


def gqa_q(q, qn_g, pos):
    B, L, _ = q.shape
    q = rms_norm(q.reshape(B, L, GQA_KV_HEADS, GQA_GROUP, GQA_DIM), qn_g)
    return rope_2d(q, *pos) if pos is not None else q


def gqa_kv(k, v, kn_g, pos):
    B, L, _ = k.shape
    k = rms_norm(k.reshape(B, L, GQA_KV_HEADS, GQA_DIM), kn_g)
    k = rope_2d(k, *pos) if pos is not None else k
    return k, v.reshape(B, L, GQA_KV_HEADS, GQA_DIM)


def short_conv(x, w):
    C = x.shape[-1]
    return lax.conv_general_dilated(
        x, w[:, None, :].astype(x.dtype), window_strides=(1,),
        padding=[(GDN_CONV // 2, GDN_CONV // 2)],
        dimension_numbers=('NWC', 'WIO', 'NWC'), feature_group_count=C)


def gdn_prep(qkv, b, a, conv_w, a_log, dt_bias):
    B, L, _ = qkv.shape
    y = jax.nn.silu(short_conv(qkv, conv_w)).astype(jnp.float32)
    q, k, v = jnp.split(y, 3, axis=-1)
    q = l2norm(q.reshape(B, L, GDN_HEADS, GDN_DK))
    k = l2norm(k.reshape(B, L, GDN_HEADS, GDN_DK))
    v = v.reshape(B, L, GDN_HEADS, GDN_DV)
    beta = jax.nn.sigmoid(b.astype(jnp.float32)).reshape(B, L, 2, GDN_HEADS)
    g = -jnp.exp(a_log.astype(jnp.float32)) * jax.nn.softplus(
        a.astype(jnp.float32).reshape(B, L, 2, GDN_HEADS) + dt_bias.astype(jnp.float32))
    return q, k, v, beta, g


def gated_delta_chunked(q, k, v, g, beta, s0):
    B, L, H, DK = q.shape
    DV = v.shape[-1]
    C = GDN_CHUNK
    N = L // C
    to_chunks = lambda t: jnp.moveaxis(t.reshape(B, N, C, H, *t.shape[3:]), 3, 1)
    q = to_chunks(q) * DK ** -0.5
    k = to_chunks(k)
    v = to_chunks(v)
    beta = to_chunks(beta)
    gc = jnp.cumsum(to_chunks(g), axis=-1)
    idx = jnp.arange(C)
    incl = idx[:, None] >= idx[None, :]
    strict = idx[:, None] > idx[None, :]
    decay = jnp.exp(jnp.where(incl, gc[..., :, None] - gc[..., None, :], -jnp.inf))
    kb = k * beta[..., None]
    kk = jnp.where(strict, jnp.einsum('bhnid,bhnjd->bhnij', kb, k) * decay, 0.0)
    rhs = jnp.concatenate([v * beta[..., None], kb * jnp.exp(gc)[..., None]], -1)
    sol = lax.linalg.triangular_solve(jnp.eye(C, dtype=q.dtype) + kk, rhs,
                                      left_side=True, lower=True)
    u, w = sol[..., :DV], sol[..., DV:]
    a_intra = jnp.einsum('bhnid,bhnjd->bhnij', q, k) * decay
    q_dec = q * jnp.exp(gc)[..., None]
    k_dec = k * jnp.exp(gc[..., -1:] - gc)[..., None]
    g_last = jnp.exp(gc[..., -1])

    def step(S, xs):
        u_i, w_i, a_i, qd_i, kd_i, gl_i = xs
        v_new = u_i - jnp.einsum('bhck,bhkv->bhcv', w_i, S)
        o_i = (jnp.einsum('bhck,bhkv->bhcv', qd_i, S)
               + jnp.einsum('bhcj,bhjv->bhcv', a_i, v_new))
        S = S * gl_i[..., None, None] + jnp.einsum('bhck,bhcv->bhkv', kd_i, v_new)
        return S, o_i

    xs = tuple(jnp.moveaxis(t, 2, 0) for t in (u, w, a_intra, q_dec, k_dec, g_last))
    S, o = lax.scan(step, s0, xs)
    o = jnp.moveaxis(jnp.moveaxis(o, 0, 2), 1, 3).reshape(B, L, H, DV)
    return o, S


def gdn_bidirectional(lat, ctx):
    ql, kl, vl, bl, gl = lat
    qc, kc, vc, bc, gcx = ctx
    s0 = jnp.zeros((qc.shape[0], GDN_HEADS, GDN_DK, GDN_DV), jnp.float32)
    o_l, o_c = None, None
    for d in range(2):
        fl = (lambda t: jnp.flip(t, axis=1)) if d == 1 else (lambda t: t)
        oc_d, s_ctx = gated_delta_chunked(fl(qc), fl(kc), fl(vc), fl(gcx[:, :, d]),
                                          fl(bc[:, :, d]), s0)
        ol_d, _ = gated_delta_chunked(fl(ql), fl(kl), fl(vl), fl(gl[:, :, d]),
                                      fl(bl[:, :, d]), s_ctx)
        o_l = fl(ol_d) if o_l is None else o_l + fl(ol_d)
        o_c = fl(oc_d) if o_c is None else o_c + fl(oc_d)
    return o_l, o_c


def merge_branches(o_mla, o_gqa, o_gdn, gate, on_g, w_out, dtype):
    B, L = o_gdn.shape[:2]
    o_gdn = rms_norm(o_gdn, on_g).reshape(B, L, GDN_WIDTH)
    o = jnp.concatenate([o_mla.astype(dtype), o_gqa.astype(dtype), o_gdn.astype(dtype)], -1)
    return (o * jax.nn.silu(gate)) @ w_out


def hybrid_layer(x, ctx, mod_lat, mod_ctx, norm_g, w_in, mla_qn_g, mla_w_uq, mla_kvn_g,
                 mla_w_ukv, gqa_qn_g, gqa_kn_g, gdn_conv_w, gdn_a_log, gdn_dt_bias,
                 gdn_on_g, w_out, pos, update_ctx):
    sh_l, sc_l, gt_l = jnp.split(mod_lat, 3, axis=-1)
    sh_c, sc_c, gt_c = jnp.split(mod_ctx, 3, axis=-1)
    h_l = rms_norm(x, norm_g) * (1 + sc_l) + sh_l
    h_c = rms_norm(ctx, norm_g) * (1 + sc_c) + sh_c
    (l_cq, l_ckv, l_kr, l_q, l_k, l_v, l_gdn, l_b, l_a, l_gate) = split_cols(h_l @ w_in)
    (c_cq, c_ckv, c_kr, c_q, c_k, c_v, c_gdn, c_b, c_a, c_gate) = split_cols(h_c @ w_in)

    kc_a, vc_a = mla_kv(c_ckv, c_kr, mla_kvn_g, mla_w_ukv, None)
    kl_a, vl_a = mla_kv(l_ckv, l_kr, mla_kvn_g, mla_w_ukv, pos)
    o_mla_l = attend(mla_q(l_cq, mla_qn_g, mla_w_uq, pos),
                     jnp.concatenate([kl_a, kc_a], 1), jnp.concatenate([vl_a, vc_a], 1), MLA_SCALE)

    kc_b, vc_b = gqa_kv(c_k, c_v, gqa_kn_g, None)
    kl_b, vl_b = gqa_kv(l_k, l_v, gqa_kn_g, pos)
    o_gqa_l = attend(gqa_q(l_q, gqa_qn_g, pos),
                     jnp.concatenate([kl_b, kc_b], 1), jnp.concatenate([vl_b, vc_b], 1), GQA_SCALE)

    o_gdn_l, o_gdn_c = gdn_bidirectional(
        gdn_prep(l_gdn, l_b, l_a, gdn_conv_w, gdn_a_log, gdn_dt_bias),
        gdn_prep(c_gdn, c_b, c_a, gdn_conv_w, gdn_a_log, gdn_dt_bias))

    x_new = x + gt_l * merge_branches(o_mla_l, o_gqa_l, o_gdn_l, l_gate, gdn_on_g, w_out, x.dtype)
    if update_ctx:
        o_mla_c = attend(mla_q(c_cq, mla_qn_g, mla_w_uq, None), kc_a, vc_a, MLA_SCALE)
        o_gqa_c = attend(gqa_q(c_q, gqa_qn_g, None), kc_b, vc_b, GQA_SCALE)
        ctx = ctx + gt_c * merge_branches(o_mla_c, o_gqa_c, o_gdn_c, c_gate, gdn_on_g, w_out, ctx.dtype)
    return x_new, ctx


def setup_inputs(seed: int = 0) -> dict:
    key = jax.random.key(seed)
    ks = jax.random.split(key, 24)
    f32 = jnp.float32
    nrm = lambda k, shape, s: s * jax.random.normal(k, shape, f32)
    gain = lambda k, shape: 1.0 + 0.02 * jax.random.normal(k, shape, f32)
    dt = jnp.exp(jax.random.uniform(ks[16], (DEPTH, 2, GDN_HEADS), f32,
                                    minval=math.log(1e-3), maxval=math.log(1e-1)))
    return {
        'x': nrm(ks[0], (BATCH, SEQ, D_MODEL), 1.0),
        'c': nrm(ks[1], (BATCH, D_MODEL), 1.0),
        'ctx': nrm(ks[2], (BATCH, CTX_LEN, D_MODEL), 1.0),
        'c_ctx': nrm(ks[3], (D_MODEL,), 1.0),
        'w_ada': nrm(ks[4], (DEPTH, D_MODEL, 3 * D_MODEL), 0.5 * D_MODEL ** -0.5),
        'b_ada': nrm(ks[5], (DEPTH, 3 * D_MODEL), 0.02),
        'norm_g': gain(ks[6], (DEPTH, D_MODEL)),
        'w_in': nrm(ks[7], (DEPTH, D_MODEL, D_IN), D_MODEL ** -0.5),
        'mla_qn_g': gain(ks[8], (DEPTH, MLA_Q_RANK)),
        'mla_w_uq': nrm(ks[9], (DEPTH, MLA_Q_RANK, MLA_HEADS * (MLA_NOPE + MLA_ROPE)), MLA_Q_RANK ** -0.5),
        'mla_kvn_g': gain(ks[10], (DEPTH, MLA_KV_RANK)),
        'mla_w_ukv': nrm(ks[11], (DEPTH, MLA_KV_RANK, MLA_HEADS * (MLA_NOPE + MLA_V)), MLA_KV_RANK ** -0.5),
        'gqa_qn_g': gain(ks[12], (DEPTH, GQA_DIM)),
        'gqa_kn_g': gain(ks[13], (DEPTH, GQA_DIM)),
        'gdn_conv_w': nrm(ks[14], (DEPTH, GDN_CONV, 3 * GDN_HEADS * GDN_DK), GDN_CONV ** -0.5),
        'gdn_a_log': jnp.log(jax.random.uniform(ks[15], (DEPTH, 2, GDN_HEADS), f32, minval=1.0, maxval=16.0)),
        'gdn_dt_bias': dt + jnp.log(-jnp.expm1(-dt)),
        'gdn_on_g': gain(ks[17], (DEPTH, GDN_DV)),
        'w_out': nrm(ks[18], (DEPTH, D_MIX, D_MODEL), D_MIX ** -0.5),
        'final_g': gain(ks[19], (D_MODEL,)),
    }


def reference(x, c, ctx, c_ctx, w_ada, b_ada, norm_g, w_in, mla_qn_g, mla_w_uq, mla_kvn_g,
              mla_w_ukv, gqa_qn_g, gqa_kn_g, gdn_conv_w, gdn_a_log, gdn_dt_bias, gdn_on_g,
              w_out, final_g):
    seq_len = x.shape[1]
    ROWS = seq_len // GRID_W
    rows = jnp.repeat(jnp.arange(ROWS, dtype=jnp.int32), GRID_W)
    cols = jnp.tile(jnp.arange(GRID_W, dtype=jnp.int32), ROWS)
    pos = (rows, cols)
    s_c = jax.nn.silu(c)
    s_cc = jax.nn.silu(c_ctx)
    for l in range(DEPTH):
        mod_lat = (s_c @ w_ada[l] + b_ada[l])[:, None, :]
        mod_ctx = s_cc @ w_ada[l] + b_ada[l]
        x, ctx = hybrid_layer(x, ctx, mod_lat, mod_ctx, norm_g[l], w_in[l], mla_qn_g[l],
                              mla_w_uq[l], mla_kvn_g[l], mla_w_ukv[l], gqa_qn_g[l], gqa_kn_g[l],
                              gdn_conv_w[l], gdn_a_log[l], gdn_dt_bias[l], gdn_on_g[l], w_out[l],
                              pos, l < DEPTH - 1)
    return rms_norm(x, final_g)
```

```cpp
#include <hip/hip_runtime.h>
#include <math.h>
#include <stdint.h>

#define DI __device__ __forceinline__

namespace v1 {
constexpr int D = 1024, NB = 16, L = 2048, LC = 256, DIN = 3120;
constexpr int BG = 2, NG = NB / BG, MLAT = BG * L, MCTX = BG * LC, MG = MLAT + MCTX;
constexpr int OFF_CQ = 0, OFF_CKV = 384, OFF_KR = 640, OFF_GQ = 672, OFF_GK = 1056, OFF_GV = 1184, OFF_GDN = 1312,
              OFF_B = 2080, OFF_A = 2088, OFF_GATE = 2096;
constexpr float EPS = 1e-6f;

DI float silu(float x) { return x / (1.f + expf(-x)); }
DI float wave_sum(float v) {
#pragma unroll
    for (int o = 32; o > 0; o >>= 1) v += __shfl_xor(v, o);
    return v;
}
DI float block_sum256(float v, float* red) {
    v = wave_sum(v);
    __syncthreads();
    if ((threadIdx.x & 63) == 0) red[threadIdx.x >> 6] = v;
    __syncthreads();
    return (red[0] + red[1]) + (red[2] + red[3]);
}
struct RowInfo { int isctx, bl, t; };
DI RowInfo decode(int r) {
    RowInfo i;
    if (r < MLAT) { i.isctx = 0; i.bl = r / L; i.t = r % L; }
    else { r -= MLAT; i.isctx = 1; i.bl = r / LC; i.t = r % LC; }
    return i;
}

__global__ void k_mod(const float* c, const float* cctx, const float* w_ada, const float* b_ada, float* mod) {
    const int j = blockIdx.x * 256 + threadIdx.x, r = blockIdx.y, l = blockIdx.z;
    const float* cv = r < 16 ? c + r * D : cctx;
    const float* w = w_ada + (size_t)l * D * 3072;
    float acc = 0.f;
    for (int k = 0; k < D; ++k) acc += silu(cv[k]) * w[(size_t)k * 3072 + j];
    mod[((size_t)l * 17 + r) * 3072 + j] = acc + b_ada[l * 3072 + j];
}

__global__ __launch_bounds__(256) void k_h(const float* xlat, const float* xctx, const float* mod_l, const float* norm_g, float* H, int g) {
    __shared__ float red[4];
    const int r = blockIdx.x, tid = threadIdx.x;
    const RowInfo ri = decode(r);
    const int b = g * BG + ri.bl;
    const float* x = ri.isctx ? xctx + ((size_t)b * LC + ri.t) * D : xlat + ((size_t)b * L + ri.t) * D;
    const float* md = mod_l + (size_t)(ri.isctx ? 16 : b) * 3072;
    float v[4], ss = 0.f;
#pragma unroll
    for (int i = 0; i < 4; ++i) { v[i] = x[tid + 256 * i]; ss += v[i] * v[i]; }
    ss = block_sum256(ss, red);
    const float rstd = 1.f / sqrtf(ss / (float)D + EPS);
#pragma unroll
    for (int i = 0; i < 4; ++i) { const int c = tid + 256 * i; H[(size_t)r * D + c] = (v[i] * rstd * norm_g[c]) * (1.f + md[1024 + c]) + md[c]; }
}

__global__ __launch_bounds__(256) void k_sgemm(const float* __restrict__ A, int lda, const float* __restrict__ B, int ldb, float* __restrict__ C, int ldc, int M, int N, int K) {
    __shared__ float As[16][68];
    __shared__ float Bs[16][68];
    const int tid = threadIdx.x, tx = tid & 15, ty = tid >> 4;
    const int m0 = blockIdx.y * 64, n0 = blockIdx.x * 64;
    float acc[4][4];
#pragma unroll
    for (int i = 0; i < 4; ++i)
#pragma unroll
        for (int j = 0; j < 4; ++j) acc[i][j] = 0.f;
    const int am = tid >> 2, ak = (tid & 3) * 4;
    const int bk = tid >> 4, bn = (tid & 15) * 4;
    for (int k0 = 0; k0 < K; k0 += 16) {
        const float4 av = *(const float4*)(A + (size_t)(m0 + am) * lda + k0 + ak);
        float4 bv = make_float4(0.f, 0.f, 0.f, 0.f);
        if (n0 + bn < N) bv = *(const float4*)(B + (size_t)(k0 + bk) * ldb + n0 + bn);
        __syncthreads();
        As[ak + 0][am] = av.x; As[ak + 1][am] = av.y; As[ak + 2][am] = av.z; As[ak + 3][am] = av.w;
        *(float4*)&Bs[bk][bn] = bv;
        __syncthreads();
#pragma unroll
        for (int k = 0; k < 16; ++k) {
            const float4 a4 = *(const float4*)&As[k][ty * 4];
            const float4 b4 = *(const float4*)&Bs[k][tx * 4];
            const float a[4] = {a4.x, a4.y, a4.z, a4.w}, b[4] = {b4.x, b4.y, b4.z, b4.w};
#pragma unroll
            for (int i = 0; i < 4; ++i)
#pragma unroll
                for (int j = 0; j < 4; ++j) acc[i][j] += a[i] * b[j];
        }
    }
    if (n0 + tx * 4 < N) {
#pragma unroll
        for (int i = 0; i < 4; ++i)
            *(float4*)(C + (size_t)(m0 + ty * 4 + i) * ldc + n0 + tx * 4) = make_float4(acc[i][0], acc[i][1], acc[i][2], acc[i][3]);
    }
}

__global__ __launch_bounds__(256) void k_post_norms(const float* P, const float* qn_g, const float* kvn_g, float* QN, float* KVN) {
    __shared__ float red[4];
    const int r = blockIdx.x, tid = threadIdx.x;
    const float* p = P + (size_t)r * DIN;
    const float a0 = p[OFF_CQ + tid], a1 = tid < 128 ? p[OFF_CQ + 256 + tid] : 0.f;
    const float ss = block_sum256(a0 * a0 + a1 * a1, red);
    const float rstd = 1.f / sqrtf(ss / 384.f + EPS);
    QN[(size_t)r * 384 + tid] = a0 * rstd * qn_g[tid];
    if (tid < 128) QN[(size_t)r * 384 + 256 + tid] = a1 * rstd * qn_g[256 + tid];
    const float b0 = p[OFF_CKV + tid];
    const float s2 = block_sum256(b0 * b0, red);
    const float rstd2 = 1.f / sqrtf(s2 / 256.f + EPS);
    KVN[(size_t)r * 256 + tid] = b0 * rstd2 * kvn_g[tid];
}

__global__ __launch_bounds__(256) void k_assemble(const float* P, float* QU, const float* KVU, float* Kmla, float* Qg, float* Kg, const float* gq_g, const float* gk_g) {
    __shared__ float krs[32];
    const int r = blockIdx.x, tid = threadIdx.x;
    const RowInfo ri = decode(r);
    const float* p = P + (size_t)r * DIN;
    const int prow = ri.t / 64, pcol = ri.t % 64;
    if (!ri.isctx && tid < 96) {
        const int h = tid / 16, pr = tid % 16, half = pr / 8, i = pr % 8;
        const int pos = half ? pcol : prow;
        const float inv = powf(10000.f, -(float)(2 * i) / 16.f), ang = (float)pos * inv, cs = cosf(ang), sn = sinf(ang);
        float* q = QU + (size_t)r * 576 + h * 96 + 64 + half * 16;
        const float x1 = q[i], x2 = q[i + 8];
        q[i] = x1 * cs - x2 * sn; q[i + 8] = x2 * cs + x1 * sn;
    }
    if (tid < 16) {
        const int half = tid / 8, i = tid % 8;
        const float x1 = p[OFF_KR + half * 16 + i], x2 = p[OFF_KR + half * 16 + i + 8];
        float o1 = x1, o2 = x2;
        if (!ri.isctx) {
            const int pos = half ? pcol : prow;
            const float inv = powf(10000.f, -(float)(2 * i) / 16.f), ang = (float)pos * inv, cs = cosf(ang), sn = sinf(ang);
            o1 = x1 * cs - x2 * sn; o2 = x2 * cs + x1 * sn;
        }
        krs[half * 16 + i] = o1; krs[half * 16 + i + 8] = o2;
    }
    __syncthreads();
    for (int e = tid; e < 576; e += 256) { const int h = e / 96, d = e % 96; Kmla[(size_t)r * 576 + e] = d < 64 ? KVU[(size_t)r * 768 + h * 128 + d] : krs[d - 64]; }
    const int w = tid >> 6, d = tid & 63;
    for (int vv = w; vv < 8; vv += 4) {
        const float x = vv < 6 ? p[OFF_GQ + vv * 64 + d] : p[OFF_GK + (vv - 6) * 64 + d];
        const float ss = wave_sum(x * x);
        const float rstd = 1.f / sqrtf(ss / 64.f + EPS);
        float y = x * rstd * (vv < 6 ? gq_g[d] : gk_g[d]);
        if (!ri.isctx) {
            const int i = d & 15, pos = (d < 32) ? prow : pcol;
            const float inv = powf(10000.f, -(float)(2 * i) / 32.f), ang = (float)pos * inv, cs = cosf(ang), sn = sinf(ang);
            const float partner = __shfl_xor(y, 16);
            y = (d & 16) ? y * cs + partner * sn : y * cs - partner * sn;
        }
        if (vv < 6) Qg[(size_t)r * 384 + vv * 64 + d] = y; else Kg[(size_t)r * 128 + (vv - 6) * 64 + d] = y;
    }
}

__global__ __launch_bounds__(256) void k_gdn_prep(const float* P, const float* conv_w, const float* a_log, const float* dt_bias, float* GQ, float* GK, float* GV, float* Gbeta, float* Gg) {
    const int r = blockIdx.x, tid = threadIdx.x;
    const RowInfo ri = decode(r);
    const int slen = ri.isctx ? LC : L;
    float y[3];
#pragma unroll
    for (int part = 0; part < 3; ++part) {
        const int c = part * 256 + tid;
        float acc = 0.f;
#pragma unroll
        for (int j = 0; j < 5; ++j) { const int tt = ri.t + j - 2; if (tt >= 0 && tt < slen) acc += P[(size_t)(r + j - 2) * DIN + OFF_GDN + c] * conv_w[j * 768 + c]; }
        y[part] = silu(acc);
    }
    const float sq = wave_sum(y[0] * y[0]), sk = wave_sum(y[1] * y[1]);
    GQ[(size_t)r * 256 + tid] = y[0] * (1.f / sqrtf(sq + EPS));
    GK[(size_t)r * 256 + tid] = y[1] * (1.f / sqrtf(sk + EPS));
    GV[(size_t)r * 256 + tid] = y[2];
    if (tid < 8) {
        const float bb = P[(size_t)r * DIN + OFF_B + tid];
        Gbeta[(size_t)r * 8 + tid] = 1.f / (1.f + expf(-bb));
        const float xa = P[(size_t)r * DIN + OFF_A + tid] + dt_bias[tid];
        const float sp = xa > 20.f ? xa : log1pf(expf(xa));
        Gg[(size_t)r * 8 + tid] = -expf(a_log[tid]) * sp;
    }
}

template <int DQ, int DV>
__global__ __launch_bounds__(128) void k_attn(const float* Q, int ldq, const float* K, int ldk, int koff, const float* V, int ldv, int voff, int vhs, float* O, int ldo, int G, float scale, int ctxq) {
    __shared__ float4 Ks[32 * DQ / 4];
    __shared__ float4 Vs[32 * DV / 4];
    const int tid = threadIdx.x, h = blockIdx.y, bl = blockIdx.z, hk = h / G;
    const int qrow = ctxq ? MLAT + bl * LC + blockIdx.x * 128 + tid : bl * L + blockIdx.x * 128 + tid;
    float q[DQ], o[DV];
#pragma unroll
    for (int d4 = 0; d4 < DQ / 4; ++d4) { const float4 t = *(const float4*)(Q + (size_t)qrow * ldq + h * DQ + d4 * 4); q[4 * d4] = t.x * scale; q[4 * d4 + 1] = t.y * scale; q[4 * d4 + 2] = t.z * scale; q[4 * d4 + 3] = t.w * scale; }
#pragma unroll
    for (int e = 0; e < DV; ++e) o[e] = 0.f;
    float m = -INFINITY, l = 0.f;
    const int kt0 = ctxq ? 64 : 0;
    for (int kt = kt0; kt < 72; ++kt) {
        const int row0 = kt < 64 ? bl * L + kt * 32 : MLAT + bl * LC + (kt - 64) * 32;
        __syncthreads();
        for (int e = tid; e < 32 * DQ / 4; e += 128) { const int kr = e / (DQ / 4), c4 = e % (DQ / 4); Ks[e] = *(const float4*)(K + (size_t)(row0 + kr) * ldk + koff + hk * DQ + c4 * 4); }
        for (int e = tid; e < 32 * DV / 4; e += 128) { const int kr = e / (DV / 4), c4 = e % (DV / 4); Vs[e] = *(const float4*)(V + (size_t)(row0 + kr) * ldv + voff + hk * vhs + c4 * 4); }
        __syncthreads();
        for (int kc = 0; kc < 32; kc += 8) {
            float s[8];
#pragma unroll
            for (int j = 0; j < 8; ++j) {
                float acc = 0.f;
#pragma unroll
                for (int d4 = 0; d4 < DQ / 4; ++d4) { const float4 kk = Ks[(kc + j) * (DQ / 4) + d4]; acc += q[4 * d4] * kk.x + q[4 * d4 + 1] * kk.y + q[4 * d4 + 2] * kk.z + q[4 * d4 + 3] * kk.w; }
                s[j] = acc;
            }
            float mx = s[0];
#pragma unroll
            for (int j = 1; j < 8; ++j) mx = fmaxf(mx, s[j]);
            const float mn = fmaxf(m, mx), alpha = expf(m - mn);
            m = mn; l *= alpha;
#pragma unroll
            for (int e = 0; e < DV; ++e) o[e] *= alpha;
#pragma unroll
            for (int j = 0; j < 8; ++j) {
                const float pj = expf(s[j] - mn);
                l += pj;
#pragma unroll
                for (int e4 = 0; e4 < DV / 4; ++e4) { const float4 vv = Vs[(kc + j) * (DV / 4) + e4]; o[4 * e4] += pj * vv.x; o[4 * e4 + 1] += pj * vv.y; o[4 * e4 + 2] += pj * vv.z; o[4 * e4 + 3] += pj * vv.w; }
            }
        }
    }
    const float il = 1.f / l;
#pragma unroll
    for (int e = 0; e < DV; ++e) O[(size_t)qrow * ldo + h * DV + e] = o[e] * il;
}

__global__ __launch_bounds__(64) void k_gdn_seq(const float* GQ, const float* GK, const float* GV, const float* Gbeta, const float* Gg, float* Og) {
    __shared__ float sk[16][64], sq[16][64], sv[16][64], sb[16], sg[16];
    __shared__ int srow[16];
    const int j = threadIdx.x, head = blockIdx.x, dir = blockIdx.y, bl = blockIdx.z;
    float S[64];
#pragma unroll
    for (int i = 0; i < 64; ++i) S[i] = 0.f;
    for (int p0 = 0; p0 < LC + L; p0 += 16) {
        __syncthreads();
        for (int i = 0; i < 16; ++i) {
            const int p = p0 + i;
            int row;
            if (p < LC) row = MLAT + bl * LC + (dir ? LC - 1 - p : p);
            else { const int pl = p - LC; row = bl * L + (dir ? L - 1 - pl : pl); }
            sk[i][j] = GK[(size_t)row * 256 + head * 64 + j];
            sq[i][j] = GQ[(size_t)row * 256 + head * 64 + j];
            sv[i][j] = GV[(size_t)row * 256 + head * 64 + j];
            if (j == 0) { srow[i] = row; sb[i] = Gbeta[(size_t)row * 8 + dir * 4 + head]; sg[i] = Gg[(size_t)row * 8 + dir * 4 + head]; }
        }
        __syncthreads();
        for (int i = 0; i < 16; ++i) {
            const float a = expf(sg[i]), bt = sb[i];
            float kS = 0.f;
#pragma unroll
            for (int ii = 0; ii < 64; ++ii) kS += sk[i][ii] * S[ii];
            const float tmp = bt * (sv[i][j] - a * kS);
            float oo = 0.f;
#pragma unroll
            for (int ii = 0; ii < 64; ++ii) { S[ii] = a * S[ii] + sk[i][ii] * tmp; oo += sq[i][ii] * S[ii]; }
            Og[((size_t)dir * MG + srow[i]) * 256 + head * 64 + j] = oo * 0.125f;
        }
    }
}

__global__ __launch_bounds__(256) void k_merge_prep(const float* P, const float* Omla, const float* Ogqa, const float* Og, const float* on_g, float* OM) {
    const int r = blockIdx.x, tid = threadIdx.x;
    const float* gate = P + (size_t)r * DIN + OFF_GATE;
    for (int c = tid; c < 384; c += 256) OM[(size_t)r * 1024 + c] = Omla[(size_t)r * 384 + c] * silu(gate[c]);
    for (int c = tid; c < 384; c += 256) OM[(size_t)r * 1024 + 384 + c] = Ogqa[(size_t)r * 384 + c] * silu(gate[384 + c]);
    const float o = Og[(size_t)r * 256 + tid] + Og[((size_t)MG + r) * 256 + tid];
    const float ss = wave_sum(o * o);
    const float rstd = 1.f / sqrtf(ss / 64.f + EPS);
    OM[(size_t)r * 1024 + 768 + tid] = o * rstd * on_g[tid & 63] * silu(gate[768 + tid]);
}

__global__ __launch_bounds__(256) void k_resid(const float* xin_lat, const float* xin_ctx, float* xout_lat, float* xout_ctx, const float* mod_l, const float* Y, int g) {
    const int r = blockIdx.x, tid = threadIdx.x;
    const RowInfo ri = decode(r);
    const int b = g * BG + ri.bl;
    const size_t off = ri.isctx ? ((size_t)b * LC + ri.t) * D : ((size_t)b * L + ri.t) * D;
    const float* src = (ri.isctx ? xin_ctx : xin_lat) + off;
    float* dst = (ri.isctx ? xout_ctx : xout_lat) + off;
    const float* gt = mod_l + (size_t)(ri.isctx ? 16 : b) * 3072 + 2048;
#pragma unroll
    for (int i = 0; i < 4; ++i) { const int c = tid + 256 * i; dst[c] = src[c] + gt[c] * Y[(size_t)r * 1024 + c]; }
}

__global__ __launch_bounds__(256) void k_final(float* out, const float* final_g) {
    __shared__ float red[4];
    const int tid = threadIdx.x;
    float* x = out + (size_t)blockIdx.x * D;
    float v[4], ss = 0.f;
#pragma unroll
    for (int i = 0; i < 4; ++i) { v[i] = x[tid + 256 * i]; ss += v[i] * v[i]; }
    ss = block_sum256(ss, red);
    const float rstd = 1.f / sqrtf(ss / (float)D + EPS);
#pragma unroll
    for (int i = 0; i < 4; ++i) { const int c = tid + 256 * i; x[c] = v[i] * rstd * final_g[c]; }
}
}

extern "C" void kernel_launch(void* const* d_in, const int* in_sizes, int n_in, void* d_out, int out_size, void* d_ws, size_t ws_size, hipStream_t stream) {
    using namespace v1;
    const float* x = (const float*)d_in[0];
    const float* c = (const float*)d_in[1];
    const float* ctx = (const float*)d_in[2];
    const float* c_ctx = (const float*)d_in[3];
    const float* w_ada = (const float*)d_in[4];
    const float* b_ada = (const float*)d_in[5];
    const float* norm_g = (const float*)d_in[6];
    const float* w_in = (const float*)d_in[7];
    const float* mla_qn_g = (const float*)d_in[8];
    const float* mla_w_uq = (const float*)d_in[9];
    const float* mla_kvn_g = (const float*)d_in[10];
    const float* mla_w_ukv = (const float*)d_in[11];
    const float* gqa_qn_g = (const float*)d_in[12];
    const float* gqa_kn_g = (const float*)d_in[13];
    const float* gdn_conv_w = (const float*)d_in[14];
    const float* gdn_a_log = (const float*)d_in[15];
    const float* gdn_dt_bias = (const float*)d_in[16];
    const float* gdn_on_g = (const float*)d_in[17];
    const float* w_out = (const float*)d_in[18];
    const float* final_g = (const float*)d_in[19];
    float* out = (float*)d_out;

    float* w = (float*)d_ws;
    size_t off = 0;
    auto take = [&](size_t n) { float* p = w + off; off += (n + 63) / 64 * 64; return p; };
    float* mod = take((size_t)2 * 17 * 3072);
    float* X1ctx = take((size_t)NB * LC * D);
    float* H = take((size_t)MG * D);
    float* P = take((size_t)MG * DIN);
    float* QN = take((size_t)MG * 384);
    float* KVN = take((size_t)MG * 256);
    float* QU = take((size_t)MG * 576);
    float* KVU = take((size_t)MG * 768);
    float* Kmla = take((size_t)MG * 576);
    float* Qg = take((size_t)MG * 384);
    float* Kg = take((size_t)MG * 128);
    float* GQ = take((size_t)MG * 256);
    float* GK = take((size_t)MG * 256);
    float* GV = take((size_t)MG * 256);
    float* Gbeta = take((size_t)MG * 8);
    float* Gg = take((size_t)MG * 8);
    float* Omla = take((size_t)MG * 384);
    float* Ogqa = take((size_t)MG * 384);
    float* Og = take((size_t)2 * MG * 256);
    float* Y = take((size_t)MG * D);
    (void)ws_size; (void)in_sizes; (void)n_in; (void)out_size;

    hipLaunchKernelGGL(k_mod, dim3(3072 / 256, 17, 2), dim3(256), 0, stream, c, c_ctx, w_ada, b_ada, mod);
    for (int l = 0; l < 2; ++l) {
        const float* xlat_in = l == 0 ? x : out;
        const float* xctx_in = l == 0 ? ctx : X1ctx;
        const float* mod_l = mod + (size_t)l * 17 * 3072;
        for (int g = 0; g < NG; ++g) {
            hipLaunchKernelGGL(k_h, dim3(MG), dim3(256), 0, stream, xlat_in, xctx_in, mod_l, norm_g + l * D, H, g);
            hipLaunchKernelGGL(k_sgemm, dim3((DIN + 63) / 64, MG / 64), dim3(256), 0, stream, H, D, w_in + (size_t)l * D * DIN, DIN, P, DIN, MG, DIN, D);
            hipLaunchKernelGGL(k_post_norms, dim3(MG), dim3(256), 0, stream, P, mla_qn_g + l * 384, mla_kvn_g + l * 256, QN, KVN);
            hipLaunchKernelGGL(k_sgemm, dim3(576 / 64, MG / 64), dim3(256), 0, stream, QN, 384, mla_w_uq + (size_t)l * 384 * 576, 576, QU, 576, MG, 576, 384);
            hipLaunchKernelGGL(k_sgemm, dim3(768 / 64, MG / 64), dim3(256), 0, stream, KVN, 256, mla_w_ukv + (size_t)l * 256 * 768, 768, KVU, 768, MG, 768, 256);
            hipLaunchKernelGGL(k_assemble, dim3(MG), dim3(256), 0, stream, P, QU, KVU, Kmla, Qg, Kg, gqa_qn_g + l * 64, gqa_kn_g + l * 64);
            hipLaunchKernelGGL(k_gdn_prep, dim3(MG), dim3(256), 0, stream, P, gdn_conv_w + (size_t)l * 5 * 768, gdn_a_log + l * 8, gdn_dt_bias + l * 8, GQ, GK, GV, Gbeta, Gg);
            hipLaunchKernelGGL((k_attn<96, 64>), dim3(L / 128, 6, BG), dim3(128), 0, stream, QU, 576, Kmla, 576, 0, KVU, 768, 64, 128, Omla, 384, 1, 0.10206207261596577f, 0);
            hipLaunchKernelGGL((k_attn<64, 64>), dim3(L / 128, 6, BG), dim3(128), 0, stream, Qg, 384, Kg, 128, 0, P, DIN, OFF_GV, 64, Ogqa, 384, 3, 0.125f, 0);
            if (l == 0) {
                hipLaunchKernelGGL((k_attn<96, 64>), dim3(LC / 128, 6, BG), dim3(128), 0, stream, QU, 576, Kmla, 576, 0, KVU, 768, 64, 128, Omla, 384, 1, 0.10206207261596577f, 1);
                hipLaunchKernelGGL((k_attn<64, 64>), dim3(LC / 128, 6, BG), dim3(128), 0, stream, Qg, 384, Kg, 128, 0, P, DIN, OFF_GV, 64, Ogqa, 384, 3, 0.125f, 1);
            }
            hipLaunchKernelGGL(k_gdn_seq, dim3(4, 2, BG), dim3(64), 0, stream, GQ, GK, GV, Gbeta, Gg, Og);
            const int mrows = l == 0 ? MG : MLAT;
            hipLaunchKernelGGL(k_merge_prep, dim3(mrows), dim3(256), 0, stream, P, Omla, Ogqa, Og, gdn_on_g + l * 64, H);
            hipLaunchKernelGGL(k_sgemm, dim3(1024 / 64, mrows / 64), dim3(256), 0, stream, H, D, w_out + (size_t)l * D * D, D, Y, D, mrows, D, D);
            hipLaunchKernelGGL(k_resid, dim3(mrows), dim3(256), 0, stream, xlat_in, xctx_in, out, X1ctx, mod_l, Y, g);
        }
    }
    hipLaunchKernelGGL(k_final, dim3(NB * L), dim3(256), 0, stream, out, final_g);
}
```

```cpp
#include <hip/hip_runtime.h>
#include <hip/hip_cooperative_groups.h>
#include <cstdio>
#include <cstdint>
#include <math.h>
namespace pg8 {
#define PG8_LAS __attribute__((address_space(3)))
typedef unsigned short bf16_t;
typedef short bf16x8 __attribute__((ext_vector_type(8)));
typedef float f32x4 __attribute__((ext_vector_type(4)));
typedef unsigned u32x4 __attribute__((ext_vector_type(4)));
constexpr int BM = 256, BK = 64, HALF = 128, HTB = HALF * BK * 2  , STAGE_BYTES = 8 * HTB, NXCD = 8, WGM = 8;

__host__ __device__ __forceinline__ int lds_byte(int r, int c) { const int st = (r >> 4) * 2 + (c >> 5), rr = r & 15, cc = c & 31, ob = rr * 64 + cc * 2; return st * 1024 + (ob ^ (((ob >> 9) & 1) << 5)); }
__host__ __device__ __forceinline__ void stage_rc(int b, int& R, int& C) { const int st = b / 1024, sb = b % 1024, swz = sb ^ (((sb >> 9) & 1) << 5); R = (st >> 1) * 16 + swz / 64; C = (st & 1) * 32 + (swz % 64) / 2; }
__host__ __device__ __forceinline__ int perm32(int rho) { const int n = rho >> 4, i = rho & 15; return 8 * (i >> 2) + 4 * n + (i & 3); }

struct Unit { int pm, pn; };
struct Gemm { const bf16_t* A; const bf16_t* Bt; int M, N, K; };

struct StaticOrder {
    int nM, nN, nwg, G, c;
    __host__ __device__ void init(int M, int N, int G_, int c_) { nM = M / BM; nN = N / BM; nwg = nM * nN; G = G_; c = c_; }
    __host__ __device__ bool next(int i, Unit& u) const {
        const long L = (long)i * G + c; if (L >= nwg) return false;
        int wgid = (int)L; { const int q = nwg / NXCD, r = nwg % NXCD, xcd = wgid % NXCD, off = wgid / NXCD; wgid = (xcd < r ? xcd * (q + 1) : r * (q + 1) + (xcd - r) * q) + off; }
        const int nig = WGM * nN, gid = wgid / nig, fm = gid * WGM, gsz = (nM - fm) < WGM ? (nM - fm) : WGM;
        u.pm = fm + ((wgid % nig) % gsz); u.pn = (wgid % nig) / gsz; return true;
    }
    __device__ __forceinline__ void a_ready(const Unit&) const {}
    __device__ __forceinline__ void done(const Unit&) const {}
};
__device__ __forceinline__ unsigned cvt_pk_bf16(float lo, float hi) { unsigned r; asm volatile("v_cvt_pk_bf16_f32 %0, %1, %2" : "=v"(r) : "v"(lo), "v"(hi)); return r; }
template <class Epi, class Sched, bool STAMP = false, bool ALIGN_EPI = false, bool SP2 = false>
__device__ __forceinline__ void gemm_phase(PG8_LAS unsigned char* lds, const Gemm g, const Sched& S, const Epi& E, unsigned long long* stamps, int tid_in) {
    int tid_ = tid_in; asm volatile("" : "+v"(tid_));
    const int tid = tid_, wid = __builtin_amdgcn_readfirstlane(tid >> 6), lane = tid & 63, wr = wid >> 2, wc = wid & 3, fr = lane & 15, fq = lane >> 4;
    const int K = g.K, nt = K / BK;
    int ts_lo = 0, ts_hi = 0, nts = 0; const unsigned long long rt_entry = STAMP ? (unsigned long long)wall_clock64() : 0ull;
#define PG8_STAMP() do { if (STAMP && wid == 0 && nts < 64) { const unsigned long long _c = (unsigned long long)clock64(); \
        ts_lo = (lane == nts) ? (int)(unsigned)_c : ts_lo; ts_hi = (lane == nts) ? (int)(unsigned)(_c >> 32) : ts_hi; ++nts; } } while (0)
    PG8_STAMP();
    unsigned voffA[2], voffB[2];
#pragma unroll
    for (int i = 0; i < 2; ++i) { int R, C; stage_rc(tid * 16 + i * 8192, R, C); const int Rb = Epi::PERM ? ((R & ~31) + perm32(R & 31)) : R;
        voffA[i] = (unsigned)(R * K + C) * 2u; voffB[i] = (unsigned)(Rb * K + C) * 2u; }
    const size_t kstep = (size_t)(BK * 2);
    const size_t hstep = (size_t)HALF * K * 2;
    const size_t tstep = 2 * hstep;
    const unsigned ldsw = (unsigned)wid * 1024u;
    const int aoff = lds_byte(wr * 64 + fr, fq * 8), boff = lds_byte(wc * 32 + fr, fq * 8);
#define PG8_SA(b, h) (((b) * 2 + (h)) * HTB)
#define PG8_SB(b, h) ((4 + (b) * 2 + (h)) * HTB)
#define PG8_STAGE(bufoff, gbase, voff) do { _Pragma("unroll") for (int _i = 0; _i < 2; ++_i) \
        __builtin_amdgcn_global_load_lds((const unsigned*)((const char*)(gbase) + (voff)[_i]), (PG8_LAS unsigned*)(lds + (bufoff) + ldsw + _i * 8192), 16, 0, 0); } while (0)
#define PG8_LDA(dst, b, h) do { _Pragma("unroll") for (int m = 0; m < 4; ++m) _Pragma("unroll") for (int k = 0; k < 2; ++k) dst[m][k] = *(const PG8_LAS bf16x8*)(lds + PG8_SA(b, h) + aoff + m * 2048 + k * 1024); } while (0)
#define PG8_LDB(dst, b, h) do { _Pragma("unroll") for (int n = 0; n < 2; ++n) _Pragma("unroll") for (int k = 0; k < 2; ++k) dst[n][k] = *(const PG8_LAS bf16x8*)(lds + PG8_SB(b, h) + boff + n * 2048 + k * 1024); } while (0)
#define PG8_MMA(ai, bj, At, Bt) do { __builtin_amdgcn_s_setprio(1); _Pragma("unroll") for (int m = 0; m < 4; ++m) _Pragma("unroll") for (int n = 0; n < 2; ++n) _Pragma("unroll") for (int k = 0; k < 2; ++k) \
        acc[ai][bj][m][n] = __builtin_amdgcn_mfma_f32_16x16x32_bf16(Bt[n][k], At[m][k], acc[ai][bj][m][n], 0, 0, 0); __builtin_amdgcn_s_setprio(0); } while (0)
#define PG8_WAIT_V(n) asm volatile("s_waitcnt vmcnt(" #n ")" ::: "memory")
#define PG8_WAIT_L(n) asm volatile("s_waitcnt lgkmcnt(" #n ")" ::: "memory")
#define PG8_BAR __builtin_amdgcn_s_barrier()
#define PG8_SCHED __builtin_amdgcn_sched_barrier(0)
    Unit cur, nxt; int ui = 0;
    if (!S.next(0, cur)) return;
    f32x4 acc[2][2][4][2];
#pragma unroll
    for (int a = 0; a < 2; ++a)
#pragma unroll
        for (int b = 0; b < 2; ++b)
#pragma unroll
            for (int m = 0; m < 4; ++m)
#pragma unroll
                for (int n = 0; n < 2; ++n) acc[a][b][m][n] = (f32x4){0.f, 0.f, 0.f, 0.f};
    bf16x8 At[4][2], B0[2][2], B1[2][2];
    const char* cA = (const char*)g.A + (size_t)cur.pm * tstep; const char* cB = (const char*)g.Bt + (size_t)cur.pn * tstep;
    S.a_ready(cur);
    if constexpr (SP2) {
        PG8_STAGE(PG8_SB(0, 0), cB, voffB); PG8_STAGE(PG8_SB(0, 1), cB + hstep, voffB); PG8_STAGE(PG8_SA(0, 0), cA, voffA); PG8_STAGE(PG8_SA(0, 1), cA + hstep, voffA);
        if (wr == 1) PG8_BAR;
        PG8_WAIT_V(2); PG8_BAR;
        PG8_STAGE(PG8_SB(1, 0), cB + kstep, voffB); PG8_STAGE(PG8_SA(1, 0), cA + kstep, voffA); PG8_STAGE(PG8_SB(1, 1), cB + hstep + kstep, voffB);
        PG8_WAIT_V(6); PG8_BAR;
    } else {
    PG8_STAGE(PG8_SB(0, 0), cB, voffB); PG8_STAGE(PG8_SA(0, 0), cA, voffA); PG8_STAGE(PG8_SB(0, 1), cB + hstep, voffB); PG8_STAGE(PG8_SA(0, 1), cA + hstep, voffA);
    if (wr == 1) PG8_BAR;
    PG8_WAIT_V(4); PG8_BAR;
    PG8_STAGE(PG8_SB(1, 0), cB + kstep, voffB); PG8_STAGE(PG8_SA(1, 0), cA + kstep, voffA); PG8_STAGE(PG8_SB(1, 1), cB + hstep + kstep, voffB);
    PG8_WAIT_V(6); PG8_BAR;
    }
    PG8_STAMP();
    for (;;) {
        const bool has_next = S.next(ui + 1, nxt);
        const char* nA = has_next ? (const char*)g.A + (size_t)nxt.pm * tstep : cA; const char* nB = has_next ? (const char*)g.Bt + (size_t)nxt.pn * tstep : cB;
#pragma unroll 1
        for (int t = 0; t < nt; t += 2) {
            const bool last = (t == nt - 2);
            const char* a1 = cA + (size_t)(t + 1) * kstep;
            const char* a2 = last ? nA : cA + (size_t)(t + 2) * kstep; const char* b2 = last ? nB : cB + (size_t)(t + 2) * kstep;
            const char* a3 = a2 + kstep; const char* b3 = b2 + kstep;
            if (last && has_next) S.a_ready(nxt);
            if constexpr (SP2) {
            PG8_LDB(B0, 0, 0); PG8_LDB(B1, 0, 1); PG8_SCHED; PG8_LDA(At, 0, 0); PG8_STAGE(PG8_SA(1, 1), a1 + hstep, voffA);
            PG8_WAIT_V(8); PG8_WAIT_L(0); PG8_BAR; PG8_MMA(0, 0, At, B0); PG8_MMA(0, 1, At, B1); PG8_BAR; PG8_SCHED;
            PG8_LDA(At, 0, 1); PG8_STAGE(PG8_SB(0, 0), b2, voffB); PG8_STAGE(PG8_SB(0, 1), b2 + hstep, voffB); PG8_STAGE(PG8_SA(0, 0), a2, voffA);
            PG8_WAIT_V(8); PG8_WAIT_L(0); PG8_BAR; PG8_MMA(1, 0, At, B0); PG8_MMA(1, 1, At, B1); PG8_BAR; PG8_SCHED;
            PG8_LDB(B0, 1, 0); PG8_LDB(B1, 1, 1); PG8_SCHED; PG8_LDA(At, 1, 0); PG8_STAGE(PG8_SA(0, 1), a2 + hstep, voffA);
            PG8_WAIT_V(8); PG8_WAIT_L(0); PG8_BAR; PG8_MMA(0, 0, At, B0); PG8_MMA(0, 1, At, B1); PG8_BAR; PG8_SCHED;
            PG8_LDA(At, 1, 1); PG8_STAGE(PG8_SB(1, 0), b3, voffB); PG8_STAGE(PG8_SB(1, 1), b3 + hstep, voffB); PG8_STAGE(PG8_SA(1, 0), a3, voffA);
            PG8_WAIT_V(8); PG8_WAIT_L(0); PG8_BAR; PG8_MMA(1, 0, At, B0); PG8_MMA(1, 1, At, B1); PG8_BAR; PG8_SCHED;
            } else {
            PG8_LDB(B0, 0, 0); PG8_SCHED; PG8_LDA(At, 0, 0); PG8_STAGE(PG8_SA(1, 1), a1 + hstep, voffA);
            PG8_WAIT_L(8); PG8_BAR; PG8_WAIT_L(0); PG8_MMA(0, 0, At, B0); PG8_BAR; PG8_SCHED;
            PG8_LDB(B1, 0, 1); PG8_STAGE(PG8_SB(0, 0), b2, voffB);
            PG8_BAR; PG8_WAIT_L(0); PG8_MMA(0, 1, At, B1); PG8_BAR;
            PG8_LDA(At, 0, 1); PG8_STAGE(PG8_SA(0, 0), a2, voffA);
            PG8_BAR; PG8_WAIT_L(0); PG8_MMA(1, 0, At, B0); PG8_BAR; PG8_SCHED;
            PG8_STAGE(PG8_SB(0, 1), b2 + hstep, voffB);
            PG8_WAIT_V(6); PG8_BAR; PG8_MMA(1, 1, At, B1); PG8_BAR;
            PG8_LDB(B0, 1, 0); PG8_SCHED; PG8_LDA(At, 1, 0); PG8_STAGE(PG8_SA(0, 1), a2 + hstep, voffA);
            PG8_WAIT_L(8); PG8_BAR; PG8_WAIT_L(0); PG8_MMA(0, 0, At, B0); PG8_BAR; PG8_SCHED;
            PG8_LDB(B1, 1, 1); PG8_STAGE(PG8_SB(1, 0), b3, voffB);
            PG8_BAR; PG8_WAIT_L(0); PG8_MMA(0, 1, At, B1); PG8_BAR;
            PG8_LDA(At, 1, 1); PG8_STAGE(PG8_SA(1, 0), a3, voffA);
            PG8_BAR; PG8_WAIT_L(0); PG8_MMA(1, 0, At, B0); PG8_BAR; PG8_SCHED;
            PG8_STAGE(PG8_SB(1, 1), b3 + hstep, voffB);
            PG8_WAIT_V(6); PG8_BAR; PG8_MMA(1, 1, At, B1); PG8_BAR;
            }
        }
        PG8_STAMP();
        if constexpr (ALIGN_EPI) { if (wr == 0) PG8_BAR; }
        if constexpr (!Epi::AFTER_DRAIN) { E(acc, cur, wr, wc, fr, fq); S.done(cur); }
        PG8_STAMP();
        if (!has_next) break;
#pragma unroll
        for (int a = 0; a < 2; ++a)
#pragma unroll
            for (int b = 0; b < 2; ++b)
#pragma unroll
                for (int m = 0; m < 4; ++m)
#pragma unroll
                    for (int n = 0; n < 2; ++n) acc[a][b][m][n] = (f32x4){0.f, 0.f, 0.f, 0.f};
        cur = nxt; cA = nA; cB = nB; ++ui;
        if constexpr (ALIGN_EPI) { if (wr == 1) PG8_BAR; }
    }
    PG8_WAIT_V(0);
    if constexpr (!ALIGN_EPI) { if (wr == 0) PG8_BAR; }
    PG8_BAR;
    if constexpr (Epi::AFTER_DRAIN) { E.fused(acc, cur, wr, wc, fr, fq, lds, wid, lane); S.done(cur); }
    PG8_STAMP();
    if (STAMP && wid == 0) { stamps[lane] = lane < nts ? (((unsigned long long)(unsigned)ts_hi << 32) | (unsigned)ts_lo) : 0ull;
        if (lane == 62) stamps[62] = rt_entry; if (lane == 63) stamps[63] = (unsigned long long)wall_clock64(); }
#undef PG8_STAMP
#undef PG8_SA
#undef PG8_SB
#undef PG8_STAGE
#undef PG8_LDA
#undef PG8_LDB
#undef PG8_MMA
#undef PG8_WAIT_V
#undef PG8_WAIT_L
#undef PG8_BAR
#undef PG8_SCHED
}
}
#define LAS __attribute__((address_space(3)))
#define DI __device__ __forceinline__
namespace mk {
typedef unsigned short bf16;
typedef unsigned u32x4 __attribute__((ext_vector_type(4)));
typedef unsigned u32x2 __attribute__((ext_vector_type(2)));
typedef float f32x4 __attribute__((ext_vector_type(4)));
constexpr int D = 1024, NB = 16, L = 2048, LC = 256, NLAT = NB * L, NCTX = NB * LC, M = NLAT + NCTX;
constexpr int NIN_PAD = 3328, NT = 512, NWAVES = 8;
constexpr int LDS_BYTES = 147456;
constexpr float EPS = 1e-6f;
constexpr int O_CQ = 0, O_CKV = 384, O_KR = 640, O_GQ = 672, O_GK = 1056, O_GV = 1184, O_GDN = 1312, O_B = 2080, O_A = 2088, O_GATE = 2096;

constexpr size_t MiB = 1u << 20;
constexpr size_t WS_CTL = 0, CTL_BYTES = 2 * MiB;
constexpr size_t CTL_SSQ = 1 * MiB;
constexpr size_t WS_MOD = 2 * MiB;
constexpr size_t WS_ROPE = WS_MOD + 512 * 1024;
constexpr size_t WS_WIN = 4 * MiB;
constexpr size_t WS_WUQ = 17 * MiB;
constexpr size_t WS_WUKV = 19 * MiB;
constexpr size_t WS_WOUT = 20 * MiB;
constexpr size_t WS_X1CTX = 24 * MiB;
constexpr size_t WS_CQ = 40 * MiB;
constexpr size_t WS_CKV = 67 * MiB;
constexpr size_t WS_KR = 85 * MiB;
constexpr size_t WS_BA = 88 * MiB;
constexpr size_t WS_GQ = 91 * MiB;
constexpr size_t WS_GK = 118 * MiB;
constexpr size_t WS_GV = 127 * MiB;
constexpr size_t WS_GDN = 136 * MiB;
constexpr size_t WS_GATE = 190 * MiB;
constexpr size_t WS_QMLA = 262 * MiB;
constexpr size_t WS_KVMLA = 303 * MiB;
constexpr size_t WS_GDNI = 357 * MiB;
constexpr size_t WS_H = WS_GDNI;
constexpr size_t WS_END = 512 * MiB;

DI unsigned f2bf(float f) { unsigned u = __builtin_bit_cast(unsigned, f); return (u + 0x7fffu + ((u >> 16) & 1u)) >> 16; }
typedef __bf16 bf2_t __attribute__((ext_vector_type(2)));
typedef float f32x2 __attribute__((ext_vector_type(2)));
DI unsigned pk2(float lo, float hi) { const f32x2 v = {lo, hi}; return __builtin_bit_cast(unsigned, __builtin_convertvector(v, bf2_t)); }
DI float bf2f(unsigned short b) { return __builtin_bit_cast(float, ((unsigned)b) << 16); }
DI float shx(float v, int mask, int lane) { return __builtin_bit_cast(float, __builtin_amdgcn_ds_bpermute((lane ^ mask) << 2, __builtin_bit_cast(int, v))); }
DI float shl_(float v, int src, int lane) { (void)lane; return __builtin_bit_cast(float, __builtin_amdgcn_ds_bpermute(src << 2, __builtin_bit_cast(int, v))); }
DI float wave_sum(float v, int lane) {
#pragma unroll
    for (int o = 32; o > 0; o >>= 1) v += shx(v, o, lane);
    return v;
}
DI float siluf(float x) { return x / (1.f + __expf(-x)); }

__host__ __device__ constexpr int rope_orig(int p) { return p < 16 ? ((p & 1) ? (p >> 1) + 8 : (p >> 1)) : 16 + (((p - 16) & 1) ? ((p - 16) >> 1) + 8 : ((p - 16) >> 1)); }

struct CmIn { DI int operator()(int n) const {
    const int hs = n >> 7, o = n & 127;
    if (hs < 3) return O_CQ + hs * 128 + o;
    if (hs == 3) return O_GK + o;
    if (hs < 6) return O_CKV + (hs - 4) * 128 + o;
    if (hs < 9) return O_GQ + (hs - 6) * 128 + o;
    if (hs == 9) return O_GV + o;
    if (hs < 16) return O_GDN + (hs - 10) * 128 + o;
    if (hs < 24) return O_GATE + (hs - 16) * 128 + o;
    if (hs == 24) { if (o < 32) return O_KR + rope_orig(o); if (o < 40) return O_B + (o - 32); if (o < 48) return O_A + (o - 40); }
    return -1; } };
struct CmUq { DI int operator()(int n) const { if (n >= 576) return -1; const int h = n / 96, d = n % 96; return d < 64 ? h * 96 + d : h * 96 + 64 + rope_orig(d - 64); } };
struct CmId { DI int operator()(int n) const { return n; } };

template <class CM> DI void wconv_item(const float* W, int K, int N, int NP, const float* kscale, bf16* Wt, int item, LAS float* scr, int lane, CM cm) {
    const int nblk = NP / 32, kb = item / nblk, nb = item % nblk, k0 = 64 * kb, n0 = 32 * nb;
    const int src = cm(n0 + (lane & 31));
#pragma unroll 8
    for (int i = 0; i < 32; ++i) { const int kk = 2 * i + (lane >> 5);
        float v = 0.f; if (src >= 0) { v = W[(size_t)(k0 + kk) * N + src]; if (kscale) v *= kscale[k0 + kk]; }
        scr[kk * 33 + (lane & 31)] = v; }
    asm volatile("s_waitcnt lgkmcnt(0)" ::: "memory");
    const int c = lane & 7;
#pragma unroll
    for (int j = 0; j < 4; ++j) { const int n = (lane >> 3) + 8 * j; const LAS float* s = scr + (8 * c) * 33 + n;
        u32x4 o; o.x = pk2(s[0 * 33], s[1 * 33]); o.y = pk2(s[2 * 33], s[3 * 33]); o.z = pk2(s[4 * 33], s[5 * 33]); o.w = pk2(s[6 * 33], s[7 * 33]);
        *(u32x4*)(Wt + (size_t)(n0 + n) * K + k0 + 8 * c) = o; }
    asm volatile("s_waitcnt lgkmcnt(0)" ::: "memory");
}

struct Ptrs {
    const float *x, *c, *ctx, *c_ctx, *w_ada, *b_ada, *norm_g, *w_in, *mla_qn_g, *mla_w_uq, *mla_kvn_g, *mla_w_ukv, *gqa_qn_g, *gqa_kn_g,
                *gdn_conv_w, *gdn_a_log, *gdn_dt_bias, *gdn_on_g, *w_out, *final_g;
    float* out; unsigned char* ws;
};

DI void p0_weights(const Ptrs& p, LAS float* scr, int gw, int ngw, int lane) {
    constexpr int I_IN = (1024 / 64) * (NIN_PAD / 32), I_UQ = (384 / 64) * (768 / 32), I_UKV = (256 / 64) * (768 / 32), I_OUT = (1024 / 64) * (1024 / 32);
    constexpr int PER_L = I_IN + I_UQ + I_UKV + I_OUT;
    for (int it = gw; it < 2 * PER_L; it += ngw) {
        const int l = it / PER_L; int r = it % PER_L;
        if (r < I_IN) { wconv_item(p.w_in + (size_t)l * 1024 * 3120, 1024, 3120, NIN_PAD, nullptr, (bf16*)(p.ws + WS_WIN) + (size_t)l * NIN_PAD * 1024, r, scr, lane, CmIn()); continue; } r -= I_IN;
        if (r < I_UQ) { wconv_item(p.mla_w_uq + (size_t)l * 384 * 576, 384, 576, 768, p.mla_qn_g + l * 384, (bf16*)(p.ws + WS_WUQ) + (size_t)l * 768 * 384, r, scr, lane, CmUq()); continue; } r -= I_UQ;
        if (r < I_UKV) { wconv_item(p.mla_w_ukv + (size_t)l * 256 * 768, 256, 768, 768, p.mla_kvn_g + l * 256, (bf16*)(p.ws + WS_WUKV) + (size_t)l * 768 * 256, r, scr, lane, CmId()); continue; } r -= I_UKV;
        wconv_item(p.w_out + (size_t)l * 1024 * 1024, 1024, 1024, 1024, nullptr, (bf16*)(p.ws + WS_WOUT) + (size_t)l * 1024 * 1024, r, scr, lane, CmId());
    }
}

DI void p0_mod(const Ptrs& p, int gtid, int ngt) {
    float* mod = (float*)(p.ws + WS_MOD);
    for (int o = gtid; o < 2 * 3072; o += ngt) {
        const int l = o / 3072, j = o % 3072;
        const float* w = p.w_ada + (size_t)l * 1024 * 3072 + j;
        float acc[17];
#pragma unroll
        for (int r = 0; r < 17; ++r) acc[r] = 0.f;
        for (int k = 0; k < 1024; ++k) {
            const float wv = w[(size_t)k * 3072];
#pragma unroll
            for (int r = 0; r < 16; ++r) { const float cv = p.c[r * 1024 + k]; acc[r] += (cv / (1.f + expf(-cv))) * wv; }
            { const float cv = p.c_ctx[k]; acc[16] += (cv / (1.f + expf(-cv))) * wv; }
        }
        const float bb = p.b_ada[l * 3072 + j];
#pragma unroll
        for (int r = 0; r < 17; ++r) mod[((size_t)l * 17 + r) * 3072 + j] = acc[r] + bb;
    }
}

DI void p1_norm(const Ptrs& p, int l, const float* xlat, const float* xctx, bool addy, int gw, int ngw, int lane) {
    const float* mod = (const float*)(p.ws + WS_MOD) + (size_t)l * 17 * 3072;
    const float* g = p.norm_g + l * 1024;
    bf16* H = (bf16*)(p.ws + WS_H);
    const int rpw = (M + ngw - 1) / ngw, rbeg = gw * rpw, rend = rbeg + rpw < M ? rbeg + rpw : M;
    f32x4 gs[4], sh[4];
    int cur_mrow = -1;
    f32x4 v0[4], v1[4]; u32x2 y0[4], y1[4];
#define MK_P1_LOAD(R_, A0, A1, Y0, Y1) do { const int _R = (R_), _R1 = _R + 1 < rend ? _R + 1 : _R; \
        const float* _x0 = _R >= NLAT ? xctx + (size_t)(_R - NLAT) * 1024 : xlat + (size_t)_R * 1024; \
        const float* _x1 = _R1 >= NLAT ? xctx + (size_t)(_R1 - NLAT) * 1024 : xlat + (size_t)_R1 * 1024; \
        _Pragma("unroll") for (int j = 0; j < 4; ++j) { A0[j] = *(const f32x4*)(_x0 + lane * 4 + 256 * j); A1[j] = *(const f32x4*)(_x1 + lane * 4 + 256 * j); } \
        if (addy) { _Pragma("unroll") for (int j = 0; j < 4; ++j) { Y0[j] = *(const u32x2*)(H + (size_t)_R * 1024 + lane * 4 + 256 * j); Y1[j] = *(const u32x2*)(H + (size_t)_R1 * 1024 + lane * 4 + 256 * j); } } } while (0)
    f32x4 n0[4], n1[4]; u32x2 ny0[4], ny1[4];
    if (rbeg < rend) MK_P1_LOAD(rbeg, v0, v1, y0, y1);
    if (rbeg + 2 < rend) MK_P1_LOAD(rbeg + 2, n0, n1, ny0, ny1);
    for (int R = rbeg; R < rend; R += 2) {
        const bool two = R + 1 < rend;
        const int R1 = two ? R + 1 : R;
        const bool more = R + 2 < rend, more2 = R + 4 < rend;
        f32x4 m0[4], m1[4]; u32x2 my0[4], my1[4];
        if (more2) MK_P1_LOAD(R + 4, m0, m1, my0, my1);
        if (addy) {
#pragma unroll
            for (int j = 0; j < 4; ++j) {
                v0[j] = (f32x4){v0[j].x + __builtin_bit_cast(float, y0[j].x << 16), v0[j].y + __builtin_bit_cast(float, y0[j].x & 0xffff0000u), v0[j].z + __builtin_bit_cast(float, y0[j].y << 16), v0[j].w + __builtin_bit_cast(float, y0[j].y & 0xffff0000u)};
                v1[j] = (f32x4){v1[j].x + __builtin_bit_cast(float, y1[j].x << 16), v1[j].y + __builtin_bit_cast(float, y1[j].x & 0xffff0000u), v1[j].z + __builtin_bit_cast(float, y1[j].y << 16), v1[j].w + __builtin_bit_cast(float, y1[j].y & 0xffff0000u)}; }
            if (R < NLAT) {
#pragma unroll
                for (int j = 0; j < 4; ++j) *(f32x4*)(p.out + (size_t)R * 1024 + lane * 4 + 256 * j) = v0[j]; }
            if (two && R1 < NLAT) {
#pragma unroll
                for (int j = 0; j < 4; ++j) *(f32x4*)(p.out + (size_t)R1 * 1024 + lane * 4 + 256 * j) = v1[j]; }
        }
#pragma unroll
        for (int rr = 0; rr < 2; ++rr) {
            if (rr == 1 && !two) break;
            const int Rr = rr ? R1 : R;
            const int mrow = Rr >= NLAT ? 16 : (Rr >> 11);
            if (mrow != cur_mrow) { cur_mrow = mrow; const float* md = mod + (size_t)mrow * 3072;
#pragma unroll
                for (int j = 0; j < 4; ++j) { const int c = lane * 4 + 256 * j; const f32x4 gg = *(const f32x4*)(g + c), sc = *(const f32x4*)(md + 1024 + c);
                    gs[j] = (f32x4){gg.x * (1.f + sc.x), gg.y * (1.f + sc.y), gg.z * (1.f + sc.z), gg.w * (1.f + sc.w)}; sh[j] = *(const f32x4*)(md + c); } }
            float ss = 0.f;
#pragma unroll
            for (int j = 0; j < 4; ++j) { const f32x4 v = rr ? v1[j] : v0[j]; ss += (v.x * v.x + v.y * v.y) + (v.z * v.z + v.w * v.w); }
            ss = wave_sum(ss, lane);
            const float rstd = 1.f / sqrtf(ss * (1.f / 1024.f) + EPS);
#pragma unroll
            for (int j = 0; j < 4; ++j) { const int c = lane * 4 + 256 * j; const f32x4 v = rr ? v1[j] : v0[j];
                u32x2 o; o.x = pk2(v.x * rstd * gs[j].x + sh[j].x, v.y * rstd * gs[j].y + sh[j].y); o.y = pk2(v.z * rstd * gs[j].z + sh[j].z, v.w * rstd * gs[j].w + sh[j].w);
                *(u32x2*)(H + (size_t)Rr * 1024 + c) = o; }
        }
        if (more) {
#pragma unroll
            for (int j = 0; j < 4; ++j) { v0[j] = n0[j]; v1[j] = n1[j]; y0[j] = ny0[j]; y1[j] = ny1[j]; }
        }
        if (more2) {
#pragma unroll
            for (int j = 0; j < 4; ++j) { n0[j] = m0[j]; n1[j] = m1[j]; ny0[j] = my0[j]; ny1[j] = my1[j]; }
        }
    }
#undef MK_P1_LOAD
}

struct EpiSeg {
    static constexpr bool PERM = true, AFTER_DRAIN = false;
    unsigned char* ws; float* ss;
    DI void operator()(const pg8::f32x4 (&acc)[2][2][4][2], const pg8::Unit& u, int wr, int wc, int fr, int fq) const {
        const int row0 = u.pm * 256 + wr * 64 + fr, colh = 32 * wc + 8 * fq;
#pragma unroll
        for (int bj = 0; bj < 2; ++bj) {
            const int hs = 2 * u.pn + bj;
            bf16* dst; int ld, c0, kind = 0;
            if (hs < 3) { dst = (bf16*)(ws + WS_CQ); ld = 384; c0 = hs * 128; kind = 1; }
            else if (hs == 3) { dst = (bf16*)(ws + WS_GK); ld = 128; c0 = 0; }
            else if (hs < 6) { dst = (bf16*)(ws + WS_CKV); ld = 256; c0 = (hs - 4) * 128; kind = 2; }
            else if (hs < 9) { dst = (bf16*)(ws + WS_GQ); ld = 384; c0 = (hs - 6) * 128; }
            else if (hs == 9) { dst = (bf16*)(ws + WS_GV); ld = 128; c0 = 0; }
            else if (hs < 16) { dst = (bf16*)(ws + WS_GDN); ld = 768; c0 = (hs - 10) * 128; }
            else if (hs < 24) { dst = (bf16*)(ws + WS_GATE); ld = 1024; c0 = (hs - 16) * 128; }
            else if (hs == 24) { dst = (bf16*)(ws + WS_KR); ld = 32; c0 = 0; kind = 3; }
            else { dst = nullptr; ld = 0; c0 = 0; kind = 4; }
            if (kind == 4) continue;
            if (kind == 3) {
                if (wc == 0) {
#pragma unroll
                    for (int ai = 0; ai < 2; ++ai)
#pragma unroll
                        for (int m = 0; m < 4; ++m) { const int row = row0 + ai * 128 + m * 16; const pg8::f32x4 v0 = acc[ai][bj][m][0], v1 = acc[ai][bj][m][1];
                            u32x4 w; w.x = pk2(v0[0], v0[1]); w.y = pk2(v0[2], v0[3]); w.z = pk2(v1[0], v1[1]); w.w = pk2(v1[2], v1[3]);
                            *(u32x4*)(dst + (size_t)row * 32 + 8 * fq) = w; }
                } else if (wc == 1 && fq < 2) {
                    float* ba = (float*)(ws + WS_BA);
#pragma unroll
                    for (int ai = 0; ai < 2; ++ai)
#pragma unroll
                        for (int m = 0; m < 4; ++m) { const int row = row0 + ai * 128 + m * 16;
                            *(pg8::f32x4*)(ba + (size_t)row * 16 + 8 * fq) = acc[ai][bj][m][0]; *(pg8::f32x4*)(ba + (size_t)row * 16 + 8 * fq + 4) = acc[ai][bj][m][1]; }
                }
                continue;
            }
#pragma unroll
            for (int ai = 0; ai < 2; ++ai)
#pragma unroll
                for (int m = 0; m < 4; ++m) { const int row = row0 + ai * 128 + m * 16; const pg8::f32x4 v0 = acc[ai][bj][m][0], v1 = acc[ai][bj][m][1];
                    u32x4 w; w.x = pk2(v0[0], v0[1]); w.y = pk2(v0[2], v0[3]); w.z = pk2(v1[0], v1[1]); w.w = pk2(v1[2], v1[3]);
                    *(u32x4*)(dst + (size_t)row * ld + c0 + colh) = w;
                    if (kind == 1 || kind == 2) {
                        float s = (v0[0] * v0[0] + v0[1] * v0[1]) + (v0[2] * v0[2] + v0[3] * v0[3]) + (v1[0] * v1[0] + v1[1] * v1[1]) + (v1[2] * v1[2] + v1[3] * v1[3]);
                        s += shx(s, 16, fr + 16 * fq); s += shx(s, 32, fr + 16 * fq);
                        if (fq == 0) atomicAdd(ss + (kind == 2 ? M : 0) + row, s);
                    } }
        }
    }
};
}

#define XB_TMO      128
#define XB_XCNT(j)  (256  + 64 * (j))
#define XB_XSUB(j)  (1280 + 64 * (j))
#define XB_XGEN(j)  (2304 + 64 * (j))
#define XB_TOP      3328
#define XB_TOPGEN   3392
#define XCD_BAR_WORDS 3456
#define XB_SPIN_CAP (1u << 18)
__device__ __forceinline__ unsigned xb_ld(unsigned* p)              { return __hip_atomic_load(p, __ATOMIC_RELAXED, __HIP_MEMORY_SCOPE_AGENT); }
__device__ __forceinline__ unsigned xb_add(unsigned* p, unsigned v) { return __hip_atomic_fetch_add(p, v, __ATOMIC_RELAXED, __HIP_MEMORY_SCOPE_AGENT); }
__device__ __forceinline__ unsigned xb_xcc_id() { return (unsigned)__builtin_amdgcn_s_getreg((3 << 11) | 20) & 0xFu; }
#define XB_SPIN(cond, bar) do { unsigned _sp = 0; while (cond) { __builtin_amdgcn_s_sleep(1); \
    if ((++_sp & 255u) == 0u) { if (xb_ld(&(bar)[XB_TMO])) break; if (_sp > XB_SPIN_CAP) { atomicAdd(&(bar)[XB_TMO], 1u); break; } } } } while (0)
struct XcdBarrier { unsigned* bar; unsigned x; volatile LAS unsigned* st; };
__device__ __forceinline__ XcdBarrier xcd_barrier_post(unsigned* bar, volatile LAS unsigned* st, int tid) {
    XcdBarrier b; b.bar = bar; b.x = xb_xcc_id(); b.st = st;
    if (tid == 0) (void)xb_add(&bar[XB_XCNT(b.x)], 1u);
    return b;
}
__device__ __forceinline__ void xcd_barrier_complete(unsigned* bar, unsigned x, unsigned& nloc, unsigned& nx) {
    const unsigned G = gridDim.x * gridDim.y * gridDim.z;
    unsigned sum, cnt, mine, sp = 0u;
    for (;;) {
        sum = 0u; cnt = 0u; mine = 0u;
#pragma unroll
        for (unsigned j = 0; j < 16; ++j) { const unsigned c = xb_ld(&bar[XB_XCNT(j)]); sum += c; cnt += (c > 0u) ? 1u : 0u; mine = (j == x) ? c : mine; }
        if (sum == G) break;
        __builtin_amdgcn_s_sleep(1);
        if ((++sp & 255u) == 0u) { if (xb_ld(&bar[XB_TMO])) break; if (sp > XB_SPIN_CAP) { atomicAdd(&bar[XB_TMO], 1u); break; } }
    }
    nloc = mine > 0u ? mine : 1u; nx = cnt > 0u ? cnt : 1u;
}
__device__ __forceinline__ void xcd_barrier(const XcdBarrier& b, int tid) {
    asm volatile("s_waitcnt vmcnt(0)" ::: "memory");
    __syncthreads();
    if (tid == 0) {
        unsigned* bar = b.bar;
        __builtin_amdgcn_s_waitcnt(0);
        unsigned nloc = b.st[0], nx = b.st[1];
        if (nloc == 0u) { xcd_barrier_complete(bar, b.x, nloc, nx); b.st[0] = nloc; b.st[1] = nx; }
        const unsigned old = xb_add(&bar[XB_XSUB(b.x)], 1u);
        const unsigned gen = old / nloc;
        if (old + 1u == (gen + 1u) * nloc) {
            __builtin_amdgcn_fence(__ATOMIC_RELEASE, "agent");
            asm volatile("s_waitcnt vmcnt(0)" ::: "memory");
            const unsigned og = xb_add(&bar[XB_TOP], 1u);
            const unsigned tg = og / nx;
            if (og + 1u == (tg + 1u) * nx) xb_add(&bar[XB_TOPGEN], 1u);
            else XB_SPIN(xb_ld(&bar[XB_TOPGEN]) == tg, bar);
            __builtin_amdgcn_fence(__ATOMIC_ACQUIRE, "agent");
            xb_add(&bar[XB_XGEN(b.x)], 1u);
            asm volatile("s_waitcnt vmcnt(0)" ::: "memory");
        } else {
            XB_SPIN(xb_ld(&bar[XB_XGEN(b.x)]) == gen, bar);
            __builtin_amdgcn_fence(__ATOMIC_ACQUIRE, "agent");
            asm volatile("s_waitcnt vmcnt(0)" ::: "memory");
        }
    }
    __syncthreads();
}
namespace mk {
DI void p0_mod(const Ptrs& p, LAS float* lds, int wg, int nwg, int tid) {
    LAS float* s = lds; LAS float* red = lds + 17 * 1024;
    float* mod = (float*)(p.ws + WS_MOD);
    for (int i = tid; i < 17 * 1024; i += NT) { const float cv = i < 16384 ? p.c[i] : p.c_ctx[i - 16384]; s[i] = cv / (1.f + expf(-cv)); }
    __syncthreads();
    for (int blk = wg; blk < 192; blk += nwg) {
        const int l = blk / 96, j0 = (blk % 96) * 32, col = tid & 31, ks = tid >> 5;
        const float* w = p.w_ada + (size_t)l * 1024 * 3072 + j0 + col;
        float acc[17];
#pragma unroll
        for (int r = 0; r < 17; ++r) acc[r] = 0.f;
        for (int kk = 0; kk < 64; ++kk) { const int k = ks * 64 + kk; const float wv = w[(size_t)k * 3072];
#pragma unroll
            for (int r = 0; r < 17; ++r) acc[r] += s[r * 1024 + k] * wv; }
#pragma unroll
        for (int r = 0; r < 17; ++r) red[(r * 16 + ks) * 32 + col] = acc[r];
        __syncthreads();
        for (int o = tid; o < 17 * 32; o += NT) { const int r = o / 32, c = o % 32; float t = 0.f;
#pragma unroll
            for (int q = 0; q < 16; ++q) t += red[(r * 16 + q) * 32 + c];
            mod[((size_t)l * 17 + r) * 3072 + j0 + c] = t + p.b_ada[l * 3072 + j0 + c]; }
        __syncthreads();
    }
}
}
namespace mk {
constexpr size_t ROPE_M_OFF = 0, ROPE_G_OFF = 64 * 8 * 2 * 4;
DI void p0_rope(const Ptrs& p, int gtid, int ngt) {
    float* tm = (float*)(p.ws + WS_ROPE + ROPE_M_OFF); float* tg = (float*)(p.ws + WS_ROPE + ROPE_G_OFF);
    for (int o = gtid; o < 64 * 8 + 64 * 16; o += ngt) {
        if (o < 512) { const int pos = o >> 3, i = o & 7; const float inv = powf(10000.f, -(float)(2 * i) / 16.f), ang = (float)pos * inv; tm[2 * o] = cosf(ang); tm[2 * o + 1] = sinf(ang); }
        else { const int q = o - 512, pos = q >> 4, i = q & 15; const float inv = powf(10000.f, -(float)(2 * i) / 32.f), ang = (float)pos * inv; tg[2 * q] = cosf(ang); tg[2 * q + 1] = sinf(ang); }
    }
}

struct EpiQup {
    static constexpr bool PERM = true, AFTER_DRAIN = false;
    bf16* Q;
    DI void operator()(const pg8::f32x4 (&acc)[2][2][4][2], const pg8::Unit& u, int wr, int wc, int fr, int fq) const {
        const int row0 = u.pm * 256 + wr * 64 + fr;
#pragma unroll
        for (int bj = 0; bj < 2; ++bj) {
            const int c = 256 * u.pn + 128 * bj + 32 * wc + 8 * fq;
            if (c >= 576) continue;
#pragma unroll
            for (int ai = 0; ai < 2; ++ai)
#pragma unroll
                for (int m = 0; m < 4; ++m) { const int row = row0 + ai * 128 + m * 16;
                    const pg8::f32x4 v0 = acc[ai][bj][m][0], v1 = acc[ai][bj][m][1];
                    u32x4 w; w.x = pk2(v0[0], v0[1]); w.y = pk2(v0[2], v0[3]); w.z = pk2(v1[0], v1[1]); w.w = pk2(v1[2], v1[3]);
                    *(u32x4*)(Q + (size_t)row * 576 + c) = w; }
        }
    }
};
struct EpiKVup {
    static constexpr bool PERM = true, AFTER_DRAIN = false;
    bf16* KV; const float* sskv;
    DI void operator()(const pg8::f32x4 (&acc)[2][2][4][2], const pg8::Unit& u, int wr, int wc, int fr, int fq) const {
        const int row0 = u.pm * 256 + wr * 64 + fr;
#pragma unroll
        for (int bj = 0; bj < 2; ++bj) {
            const int c = 256 * u.pn + 128 * bj + 32 * wc + 8 * fq;
#pragma unroll
            for (int ai = 0; ai < 2; ++ai)
#pragma unroll
                for (int m = 0; m < 4; ++m) { const int row = row0 + ai * 128 + m * 16;
                    const float rstd = 1.f / sqrtf(sskv[row] * (1.f / 256.f) + EPS);
                    const pg8::f32x4 v0 = acc[ai][bj][m][0] * rstd, v1 = acc[ai][bj][m][1] * rstd;
                    u32x4 w; w.x = pk2(v0[0], v0[1]); w.y = pk2(v0[2], v0[3]); w.z = pk2(v1[0], v1[1]); w.w = pk2(v1[2], v1[3]);
                    *(u32x4*)(KV + (size_t)row * 768 + c) = w; }
        }
    }
};

DI void p3_qknorm(const Ptrs& p, int l, int gw, int ngw, int lane) {
    bf16* GQ = (bf16*)(p.ws + WS_GQ); bf16* GK = (bf16*)(p.ws + WS_GK); bf16* KR = (bf16*)(p.ws + WS_KR);
    const float* ropeM = (const float*)(p.ws + WS_ROPE + ROPE_M_OFF); const float* ropeG = (const float*)(p.ws + WS_ROPE + ROPE_G_OFF);
    const bool isq = lane < 48;
    const int l8 = lane & 7, dbase = 8 * l8;
    const float* gain = (isq ? p.gqa_qn_g : p.gqa_kn_g) + l * 64 + dbase;
    float gn[8];
#pragma unroll
    for (int j = 0; j < 8; ++j) gn[j] = gain[j];
    const int rpw = (M + ngw - 1) / ngw, rbeg = gw * rpw, rend = rbeg + rpw < M ? rbeg + rpw : M;
    u32x4 raw2[2], kraw2[2];
#define MK_QKN_LOAD(Rb_, RAW, KRAW) do { _Pragma("unroll") for (int rr = 0; rr < 2; ++rr) { const int R = (rr && (Rb_) + 1 < rend) ? (Rb_) + 1 : (Rb_); \
            RAW[rr] = *(const u32x4*)(isq ? GQ + (size_t)R * 384 + lane * 8 : GK + (size_t)R * 128 + (lane - 48) * 8); \
            KRAW[rr] = (R < NLAT && lane < 4) ? *(const u32x4*)(KR + (size_t)R * 32 + lane * 8) : (u32x4){0u, 0u, 0u, 0u}; } } while (0)
    if (rbeg < rend) MK_QKN_LOAD(rbeg, raw2, kraw2);
    for (int Rb = rbeg; Rb < rend; Rb += 2) {
        const bool two = Rb + 1 < rend;
        const bool more = Rb + 2 < rend;
        u32x4 nraw2[2], nkraw2[2];
        if (more) MK_QKN_LOAD(Rb + 2, nraw2, nkraw2);
#pragma unroll
        for (int rr = 0; rr < 2; ++rr) {
            if (rr == 1 && !two) break;
            const int R = Rb + rr;
            bf16* ptr = isq ? GQ + (size_t)R * 384 + lane * 8 : GK + (size_t)R * 128 + (lane - 48) * 8;
            const u32x4 raw = raw2[rr];
            float x[8];
            x[0] = __builtin_bit_cast(float, raw.x << 16); x[1] = __builtin_bit_cast(float, raw.x & 0xffff0000u);
            x[2] = __builtin_bit_cast(float, raw.y << 16); x[3] = __builtin_bit_cast(float, raw.y & 0xffff0000u);
            x[4] = __builtin_bit_cast(float, raw.z << 16); x[5] = __builtin_bit_cast(float, raw.z & 0xffff0000u);
            x[6] = __builtin_bit_cast(float, raw.w << 16); x[7] = __builtin_bit_cast(float, raw.w & 0xffff0000u);
            float ss = 0.f;
#pragma unroll
            for (int j = 0; j < 8; ++j) ss += x[j] * x[j];
            ss += shx(ss, 1, lane); ss += shx(ss, 2, lane); ss += shx(ss, 4, lane);
            const float rstd = 1.f / sqrtf(ss * (1.f / 64.f) + EPS);
            float y[8];
#pragma unroll
            for (int j = 0; j < 8; ++j) y[j] = x[j] * rstd * gn[j];
            if (R < NLAT) {
                const int t = R & 2047, pos = (l8 < 4) ? (t >> 6) : (t & 63), i0 = 8 * (l8 & 1);
                const float* tb = ropeG + (pos * 16 + i0) * 2;
                const bool upper = (l8 & 2) != 0;
#pragma unroll
                for (int j = 0; j < 8; ++j) { const float partner = shx(y[j], 2, lane); const float cs = tb[2 * j], sn = tb[2 * j + 1];
                    y[j] = upper ? y[j] * cs + partner * sn : y[j] * cs - partner * sn; }
            }
            u32x4 o; o.x = pk2(y[0], y[1]); o.y = pk2(y[2], y[3]); o.z = pk2(y[4], y[5]); o.w = pk2(y[6], y[7]);
            *(u32x4*)ptr = o;
            if (R < NLAT && lane < 4) {
                bf16* kp = KR + (size_t)R * 32 + lane * 8;
                const u32x4 kraw = kraw2[rr];
                const int t = R & 2047, p0 = 8 * lane, pos = p0 < 16 ? (t >> 6) : (t & 63), i0 = (p0 & 15) >> 1;
                const float* tb = ropeM + (pos * 8 + i0) * 2;
                const unsigned w[4] = {kraw.x, kraw.y, kraw.z, kraw.w}; unsigned ow[4];
#pragma unroll
                for (int j = 0; j < 4; ++j) { const float x1 = __builtin_bit_cast(float, w[j] << 16), x2 = __builtin_bit_cast(float, w[j] & 0xffff0000u), cs = tb[2 * j], sn = tb[2 * j + 1];
                    ow[j] = pk2(x1 * cs - x2 * sn, x2 * cs + x1 * sn); }
                *(u32x4*)kp = (u32x4){ow[0], ow[1], ow[2], ow[3]};
            }
        }
        if (more) { raw2[0] = nraw2[0]; raw2[1] = nraw2[1]; kraw2[0] = nkraw2[0]; kraw2[1] = nkraw2[1]; }
    }
#undef MK_QKN_LOAD
}
}
namespace mk {
typedef short bf16x8 __attribute__((ext_vector_type(8)));
typedef short s16x4 __attribute__((ext_vector_type(4)));
typedef float f32x16 __attribute__((ext_vector_type(16)));
#define MK_SBAR() __builtin_amdgcn_sched_barrier(0)
#define MK_MFMA32(a, b, c) __builtin_amdgcn_mfma_f32_32x32x16_bf16((a), (b), (c), 0, 0, 0)
template <int OFF> DI s16x4 tr_read(unsigned addr) { s16x4 r; asm volatile("ds_read_b64_tr_b16 %0, %1 offset:%2" : "=&v"(r) : "v"(addr), "i"(OFF) : "memory"); return r; }
DI float lo_bf(unsigned w) { return __builtin_bit_cast(float, w << 16); }
DI float hi_bf(unsigned w) { return __builtin_bit_cast(float, w & 0xffff0000u); }
DI bf16x8 pack8(const f32x16& x, int base) {
    u32x4 w; w.x = pk2(x[base + 0], x[base + 1]); w.y = pk2(x[base + 2], x[base + 3]); w.z = pk2(x[base + 4], x[base + 5]); w.w = pk2(x[base + 6], x[base + 7]);
    return __builtin_bit_cast(bf16x8, w);
}
template <int DVT> DI void pv_one(f32x16& od, unsigned vb, bf16x8 pb0, bf16x8 pb1, bf16x8 pb2, bf16x8 pb3) {
    const s16x4 l0 = tr_read<DVT * 4096 + 0>(vb), h0 = tr_read<DVT * 4096 + 512>(vb), l1 = tr_read<DVT * 4096 + 1024>(vb), h1 = tr_read<DVT * 4096 + 1536>(vb);
    const s16x4 l2 = tr_read<DVT * 4096 + 2048>(vb), h2 = tr_read<DVT * 4096 + 2560>(vb), l3 = tr_read<DVT * 4096 + 3072>(vb), h3 = tr_read<DVT * 4096 + 3584>(vb);
    asm volatile("s_waitcnt lgkmcnt(0)" ::: "memory"); MK_SBAR();
#define MK_PKV(L, H) (bf16x8){L[0], L[1], L[2], L[3], H[0], H[1], H[2], H[3]}
    od = MK_MFMA32(MK_PKV(l0, h0), pb0, od); od = MK_MFMA32(MK_PKV(l1, h1), pb1, od); od = MK_MFMA32(MK_PKV(l2, h2), pb2, od); od = MK_MFMA32(MK_PKV(l3, h3), pb3, od);
#undef MK_PKV
}

template <bool MLA>
DI void attn_unit(const Ptrs& p, int l, LAS unsigned char* lds, int b, int h, int qb, bool ctxq, int tid) {
    asm volatile("" : "+v"(tid));
    constexpr int DQ = MLA ? 96 : 64, NS = DQ / 16, KSTR = DQ * 2 + 16, KBUF = 64 * KSTR, VBUF = 8192, CPR = DQ / 8;
    constexpr float LOG2E = 1.4426950408889634f, THR2 = 8.f * LOG2E;
    const int wave = tid >> 6, lane = tid & 63, r32 = lane & 31, hh = lane >> 5;
    const int qrow = (ctxq ? NLAT + b * 256 : b * 2048 + qb * 256) + wave * 32 + r32;
    const int hk = MLA ? h : h / 3;
    const bf16* Ksrc = MLA ? (const bf16*)(p.ws + WS_KVMLA) + hk * 128 : (const bf16*)(p.ws + WS_GK) + hk * 64;
    const bf16* Vsrc = MLA ? (const bf16*)(p.ws + WS_KVMLA) + hk * 128 + 64 : (const bf16*)(p.ws + WS_GV) + hk * 64;
    const bf16* KRsrc = (const bf16*)(p.ws + WS_KR);
    constexpr int LDKV = MLA ? 768 : 128;
    bf16x8 qf[NS];
    float c_lane;
    {
        const bf16* qp = MLA ? (const bf16*)(p.ws + WS_QMLA) + (size_t)qrow * 576 + h * 96 + hh * 8 : (const bf16*)(p.ws + WS_GQ) + (size_t)qrow * 384 + h * 64 + hh * 8;
#pragma unroll
        for (int s = 0; s < NS; ++s) qf[s] = *(const bf16x8*)(qp + 16 * s);
        if constexpr (MLA) {
            const float ssq = ((const float*)(p.ws + CTL_SSQ))[(size_t)l * 2 * M + qrow];
            c_lane = 0.10206207261596577f * LOG2E / sqrtf(ssq * (1.f / 384.f) + EPS);
            if (!ctxq) {
                const float* ropeM = (const float*)(p.ws + WS_ROPE + ROPE_M_OFF);
                const int t = qrow & 2047;
#pragma unroll
                for (int s = 4; s < 6; ++s) {
                    const int pos = s == 4 ? (t >> 6) : (t & 63);
                    const f32x4 cs0 = *(const f32x4*)(ropeM + (pos * 8 + 4 * hh) * 2), cs1 = *(const f32x4*)(ropeM + (pos * 8 + 4 * hh + 2) * 2);
                    const u32x4 w = __builtin_bit_cast(u32x4, qf[s]);
                    u32x4 o;
                    { const float x1 = lo_bf(w.x), x2 = hi_bf(w.x); o.x = pk2(x1 * cs0.x - x2 * cs0.y, x2 * cs0.x + x1 * cs0.y); }
                    { const float x1 = lo_bf(w.y), x2 = hi_bf(w.y); o.y = pk2(x1 * cs0.z - x2 * cs0.w, x2 * cs0.z + x1 * cs0.w); }
                    { const float x1 = lo_bf(w.z), x2 = hi_bf(w.z); o.z = pk2(x1 * cs1.x - x2 * cs1.y, x2 * cs1.x + x1 * cs1.y); }
                    { const float x1 = lo_bf(w.w), x2 = hi_bf(w.w); o.w = pk2(x1 * cs1.z - x2 * cs1.w, x2 * cs1.z + x1 * cs1.w); }
                    qf[s] = __builtin_bit_cast(bf16x8, o);
                }
            }
        } else c_lane = 0.125f * LOG2E;
#pragma unroll
        for (int s = 0; s < NS; ++s) { const u32x4 w = __builtin_bit_cast(u32x4, qf[s]); u32x4 o;
            o.x = pk2(lo_bf(w.x) * c_lane, hi_bf(w.x) * c_lane); o.y = pk2(lo_bf(w.y) * c_lane, hi_bf(w.y) * c_lane);
            o.z = pk2(lo_bf(w.z) * c_lane, hi_bf(w.z) * c_lane); o.w = pk2(lo_bf(w.w) * c_lane, hi_bf(w.w) * c_lane); qf[s] = __builtin_bit_cast(bf16x8, o); }
    }
    float m2 = 0.f;
    if constexpr (!MLA) {
        float gq = fabsf(p.gqa_qn_g[l * 64 + lane]), gk = fabsf(p.gqa_kn_g[l * 64 + lane]);
#pragma unroll
        for (int o = 32; o > 0; o >>= 1) { gq = fmaxf(gq, shx(gq, o, lane)); gk = fmaxf(gk, shx(gk, o, lane)); }
        m2 = 64.f * gq * gk * 0.125f * LOG2E * 1.01f;
    }
    const int e0 = tid, e1 = tid + 512;
    const int k0key = e0 / CPR, k0c = e0 % CPR, k1key = e1 / CPR, k1c = e1 % CPR;
    const bool has1 = e1 < 64 * CPR;
    const int vkey = tid >> 3, vc8 = tid & 7;
    const int kw0 = k0key * KSTR + k0c * 16, kw1 = k1key * KSTR + k1c * 16, vw = (vc8 >> 2) * 4096 + vkey * 64 + (vc8 & 3) * 16;
    LAS unsigned char* Kl = lds; LAS unsigned char* Vl = lds + 2 * KBUF;
    const bool k0r = MLA && k0c >= 8, k1r = MLA && k1c >= 8;
    const bf16* ks0 = k0r ? KRsrc + (size_t)k0key * 32 + (k0c - 8) * 8 : Ksrc + (size_t)k0key * LDKV + k0c * 8;
    const bf16* ks1 = k1r ? KRsrc + (size_t)k1key * 32 + (k1c - 8) * 8 : Ksrc + (size_t)k1key * LDKV + k1c * 8;
    const int ks0s = k0r ? 32 : LDKV, ks1s = k1r ? 32 : LDKV;
    const bf16* vs0 = Vsrc + (size_t)vkey * LDKV + vc8 * 8;
    u32x4 kr0, kr1, vr;
    const int kt0 = ctxq ? 32 : 0, kt1 = 36;
#define MK_ROW0(kt) ((kt) < 32 ? b * 2048 + (kt) * 64 : NLAT + b * 256 + ((kt) - 32) * 64)
#define MK_SLOAD(kt) do { const int _r0 = MK_ROW0(kt); \
        kr0 = *(const u32x4*)(ks0 + (size_t)_r0 * ks0s); if (has1) kr1 = *(const u32x4*)(ks1 + (size_t)_r0 * ks1s); vr = *(const u32x4*)(vs0 + (size_t)_r0 * LDKV); } while (0)
#define MK_SWRITE(buf) do { *(LAS u32x4*)(Kl + (buf) * KBUF + kw0) = kr0; if (has1) *(LAS u32x4*)(Kl + (buf) * KBUF + kw1) = kr1; *(LAS u32x4*)(Vl + (buf) * VBUF + vw) = vr; } while (0)
    const int ka = r32 * KSTR + hh * 16;
    const unsigned vb0 = (unsigned)(uintptr_t)(Vl) + (unsigned)((4 * hh + ((lane & 15) >> 2)) * 64 + 32 * ((lane >> 4) & 1) + 8 * (lane & 3));
    f32x16 o0 = {}, o1 = {};
    float lsum = 0.f;
    f32x16 pA0, pA1, pB0, pB1;
    bf16x8 pb0, pb1, pb2, pb3;
#define MK_QK(P0, P1, kt) do { const float _nm = -m2; _Pragma("unroll") for (int r = 0; r < 16; ++r) { P0[r] = _nm; P1[r] = _nm; } const LAS unsigned char* kb = Kl + ((kt) & 1) * KBUF + ka; \
        _Pragma("unroll") for (int s = 0; s < NS; ++s) { const bf16x8 a0 = *(const LAS bf16x8*)(kb + s * 32), a1 = *(const LAS bf16x8*)(kb + 32 * KSTR + s * 32); \
            P0 = MK_MFMA32(a0, qf[s], P0); P1 = MK_MFMA32(a1, qf[s], P1); } } while (0)
#define MK_FINISH(P0, P1) do { f32x2 ps2 = {0.f, 0.f}; \
        _Pragma("unroll") for (int r = 0; r < 16; r += 2) { P0[r] = __builtin_amdgcn_exp2f(P0[r]); P0[r + 1] = __builtin_amdgcn_exp2f(P0[r + 1]); ps2 += (f32x2){P0[r], P0[r + 1]}; } \
        _Pragma("unroll") for (int r = 0; r < 16; r += 2) { P1[r] = __builtin_amdgcn_exp2f(P1[r]); P1[r + 1] = __builtin_amdgcn_exp2f(P1[r + 1]); ps2 += (f32x2){P1[r], P1[r + 1]}; } \
        lsum += ps2.x + ps2.y; pb0 = pack8(P0, 0); pb1 = pack8(P0, 8); pb2 = pack8(P1, 0); pb3 = pack8(P1, 8); } while (0)
#define MK_PV(kt) do { const unsigned vb = vb0 + ((kt) % 3) * VBUF; pv_one<0>(o0, vb, pb0, pb1, pb2, pb3); pv_one<1>(o1, vb, pb0, pb1, pb2, pb3); } while (0)
#define MK_DECIDE(P0, P1) do { if constexpr (MLA) { float tmax = P0[0]; \
        _Pragma("unroll") for (int r = 1; r < 16; ++r) tmax = fmaxf(tmax, P0[r]); \
        _Pragma("unroll") for (int r = 0; r < 16; ++r) tmax = fmaxf(tmax, P1[r]); \
        { const auto rr = __builtin_amdgcn_permlane32_swap(__float_as_uint(tmax), __float_as_uint(tmax), false, false); tmax = fmaxf(__uint_as_float(rr[0]), __uint_as_float(rr[1])); } \
        if (__any(tmax > THR2)) { const float dm = fmaxf(tmax, 0.f), alpha = __builtin_amdgcn_exp2f(-dm); m2 += dm; lsum *= alpha; \
            _Pragma("unroll") for (int r = 0; r < 16; ++r) { o0[r] *= alpha; o1[r] *= alpha; P0[r] -= dm; P1[r] -= dm; } } } } while (0)
#define MK_SWRITE3(t) do { *(LAS u32x4*)(Kl + ((t) & 1) * KBUF + kw0) = kr0; if (has1) *(LAS u32x4*)(Kl + ((t) & 1) * KBUF + kw1) = kr1; *(LAS u32x4*)(Vl + ((t) % 3) * VBUF + vw) = vr; } while (0)
#define MK_ITER(j, C0, C1, R0_, R1_) do { const int _t = kt0 + (j); if ((j) + 1 < NT_) MK_SLOAD(_t + 1); \
        MK_QK(C0, C1, _t); MK_FINISH(R0_, R1_); MK_PV(_t - 1); MK_DECIDE(C0, C1); \
        if ((j) + 1 < NT_) MK_SWRITE3(_t + 1); __syncthreads(); } while (0)
    const int NT_ = kt1 - kt0;
    MK_SLOAD(kt0);
    __syncthreads();
    MK_SWRITE3(kt0);
    MK_SLOAD(kt0 + 1);
    __syncthreads();
    MK_QK(pA0, pA1, kt0); MK_DECIDE(pA0, pA1);
    MK_SWRITE3(kt0 + 1);
    __syncthreads();
    for (int j = 1; j + 1 < NT_; j += 2) {
        MK_ITER(j, pB0, pB1, pA0, pA1);
        MK_ITER(j + 1, pA0, pA1, pB0, pB1);
    }
    bf16* gp = (bf16*)(p.ws + WS_GATE) + (size_t)qrow * 1024 + (MLA ? 0 : 384) + h * 64 + 8 * hh;
    u32x4 gv[2][2];
#pragma unroll
    for (int tl = 0; tl < 2; ++tl)
#pragma unroll
        for (int pr = 0; pr < 2; ++pr) gv[tl][pr] = *(const u32x4*)(gp + 32 * tl + 16 * pr);
    MK_ITER(NT_ - 1, pB0, pB1, pA0, pA1);
    MK_FINISH(pB0, pB1); MK_PV(kt1 - 1);
#undef MK_QK
#undef MK_FINISH
#undef MK_PV
#undef MK_DECIDE
#undef MK_SWRITE3
#undef MK_ITER
    { const auto rr = __builtin_amdgcn_permlane32_swap(__float_as_uint(lsum), __float_as_uint(lsum), false, false); lsum = __uint_as_float(rr[0]) + __uint_as_float(rr[1]); }
    const float inv = 1.f / lsum;
#pragma unroll
    for (int tl = 0; tl < 2; ++tl)
#pragma unroll
        for (int pr = 0; pr < 2; ++pr) {
            float v[8];
#pragma unroll
            for (int e = 0; e < 4; ++e) {
                const float lo = tl ? o1[8 * pr + e] : o0[8 * pr + e], hi = tl ? o1[8 * pr + 4 + e] : o0[8 * pr + 4 + e];
                const auto rr = __builtin_amdgcn_permlane32_swap(__float_as_uint(lo), __float_as_uint(hi), false, false);
                v[e] = __uint_as_float(rr[0]); v[4 + e] = __uint_as_float(rr[1]);
            }
            const u32x4 gw = gv[tl][pr];
            u32x4 ow;
            ow.x = pk2(v[0] * inv * siluf(lo_bf(gw.x)), v[1] * inv * siluf(hi_bf(gw.x))); ow.y = pk2(v[2] * inv * siluf(lo_bf(gw.y)), v[3] * inv * siluf(hi_bf(gw.y)));
            ow.z = pk2(v[4] * inv * siluf(lo_bf(gw.z)), v[5] * inv * siluf(hi_bf(gw.z))); ow.w = pk2(v[6] * inv * siluf(lo_bf(gw.w)), v[7] * inv * siluf(hi_bf(gw.w)));
            *(u32x4*)(gp + 32 * tl + 16 * pr) = ow;
        }
#undef MK_ROW0
#undef MK_SLOAD
#undef MK_SWRITE
}

typedef short v4i16_t __attribute__((ext_vector_type(4)));
DI s16x4 vtr_(const LAS unsigned char* p) { return __builtin_bit_cast(s16x4, __builtin_amdgcn_ds_read_tr16_b64_v4i16((LAS v4i16_t*)p)); }
DI void glds16(const void* g, unsigned lds_base) {
    unsigned sv; asm volatile("s_mov_b32 %0, m0\n\ts_mov_b32 m0, %2\n\ts_nop 0\n\tglobal_load_lds_dwordx4 %1, off\n\ts_mov_b32 m0, %0" : "=&s"(sv) : "v"(g), "s"(lds_base) : "memory"); }
#define MK_WAIT_BAR(N) asm volatile("s_waitcnt vmcnt(" #N ") lgkmcnt(0)\n\ts_barrier" ::: "memory")
DI void attn_unit_g(const Ptrs& p, int l, LAS unsigned char* lds, int b, int h, int qb, bool ctxq, int tid) {
    asm volatile("" : "+v"(tid));
    constexpr float LOG2E = 1.4426950408889634f;
    constexpr int PK_ = 128, SLOTB = 8192, LDS_K = 0, LDS_V = 3 * SLOTB;
    const int lane = tid & 63, r32 = lane & 31, hi = lane >> 5; const int wid = __builtin_amdgcn_readfirstlane(tid >> 6);
    const int qrow = (ctxq ? NLAT + b * 256 : b * 2048 + qb * 256) + wid * 32 + r32;
    const int hk = h / 3;
    const bf16* Ksrc = (const bf16*)(p.ws + WS_GK) + hk * 64; const bf16* Vsrc = (const bf16*)(p.ws + WS_GV) + hk * 64;
    const unsigned lds0 = (unsigned)(uintptr_t)lds;
    const bf16* ksrc = Ksrc + (size_t)lane * PK_ + wid * 8;
    const bf16* vsrc = Vsrc + (size_t)(16 * (wid & 3) + (lane >> 2)) * PK_ + (wid >> 2) * 32 + (lane & 3) * 8;
    const unsigned kdst = lds0 + LDS_K + wid * 1024, vdst = lds0 + LDS_V + wid * 1024;
    const int kt0 = ctxq ? 32 : 0, NT = 36 - kt0;
#define MK_GROW0(t) (((t) + kt0) < 32 ? b * 2048 + ((t) + kt0) * 64 : NLAT + b * 256 + ((t) + kt0 - 32) * 64)
#define DMA_K(t, slot) glds16(ksrc + (size_t)MK_GROW0(t) * PK_, (unsigned)__builtin_amdgcn_readfirstlane(kdst + (slot)))
#define DMA_V(t, slot) glds16(vsrc + (size_t)MK_GROW0(t) * PK_, (unsigned)__builtin_amdgcn_readfirstlane(vdst + (slot)))
    const LAS unsigned char* kp0 = lds + LDS_K + hi * 1024 + r32 * 16;
    const LAS unsigned char* vp0 = lds + LDS_V + ((lane >> 4) & 1) * 32 + (lane & 3) * 8 + (4 * hi + ((lane & 15) >> 2)) * 64;
    const unsigned vb0u = lds0 + LDS_V + (unsigned)(((lane >> 4) & 1) * 32 + (lane & 3) * 8 + (4 * hi + ((lane & 15) >> 2)) * 64);
    bf16x8 kf[8];
    DMA_K(0, 0); DMA_V(0, 0); DMA_K(1, SLOTB);
    bf16x8 qr[4];
    {
        const bf16* qp = (const bf16*)(p.ws + WS_GQ) + (size_t)qrow * 384 + h * 64 + hi * 8;
#pragma unroll
        for (int s = 0; s < 4; ++s) qr[s] = *(const bf16x8*)(qp + 16 * s);
        const float c_lane = 0.125f * LOG2E;
#pragma unroll
        for (int s = 0; s < 4; ++s) { const u32x4 w = __builtin_bit_cast(u32x4, qr[s]); u32x4 o;
            o.x = pk2(lo_bf(w.x) * c_lane, hi_bf(w.x) * c_lane); o.y = pk2(lo_bf(w.y) * c_lane, hi_bf(w.y) * c_lane);
            o.z = pk2(lo_bf(w.z) * c_lane, hi_bf(w.z) * c_lane); o.w = pk2(lo_bf(w.w) * c_lane, hi_bf(w.w) * c_lane); qr[s] = __builtin_bit_cast(bf16x8, o); }
    }
    f32x16 negm;
    {
        float gq = fabsf(p.gqa_qn_g[l * 64 + lane]), gk = fabsf(p.gqa_kn_g[l * 64 + lane]);
#pragma unroll
        for (int o = 32; o > 0; o >>= 1) { gq = fmaxf(gq, shx(gq, o, lane)); gk = fmaxf(gk, shx(gk, o, lane)); }
        const float nm = -(64.f * gq * gk * 0.125f * LOG2E * 1.01f);
#pragma unroll
        for (int r = 0; r < 16; ++r) negm[r] = nm;
        asm volatile("" : "+v"(negm));
    }
    f32x16 o0 = {}, o1 = {}; float l_reg = 0.f;
    f32x16 pA0, pA1, pB0, pB1;
    int sl_prev = 0, sl_cur = 0, sl_next = SLOTB;
#define ROT() do { sl_prev = sl_cur; sl_cur = sl_next; sl_next = (sl_next == 2 * SLOTB) ? 0 : sl_next + SLOTB; } while (0)
    DMA_K(2, 2 * SLOTB);
    MK_WAIT_BAR(3);
    {
#pragma unroll
        for (int d0 = 0; d0 < 4; ++d0) {
            const bf16x8 b0 = *(const LAS bf16x8*)(kp0 + d0 * 2048), b1 = *(const LAS bf16x8*)(kp0 + d0 * 2048 + 512);
            if (d0 == 0) { pA0 = MK_MFMA32(b0, qr[0], negm); pA1 = MK_MFMA32(b1, qr[0], negm); }
            else { pA0 = MK_MFMA32(b0, qr[d0], pA0); pA1 = MK_MFMA32(b1, qr[d0], pA1); }
        }
#pragma unroll
        for (int r = 0; r < 16; ++r) { pA0[r] = __builtin_amdgcn_exp2f(pA0[r]); pA1[r] = __builtin_amdgcn_exp2f(pA1[r]); }
    }
    MK_WAIT_BAR(0);
    DMA_K(3, 0); DMA_V(1, SLOTB);
    ROT();
#define KLOAD2(kp, j) do { kf[2 * (j)] = *(const LAS bf16x8*)((kp) + (j) * 2048); kf[2 * (j) + 1] = *(const LAS bf16x8*)((kp) + (j) * 2048 + 512); } while (0)
    { const LAS unsigned char* kp = kp0 + sl_cur; KLOAD2(kp, 0); KLOAD2(kp, 1); KLOAD2(kp, 2); KLOAD2(kp, 3); }
    MK_WAIT_BAR(2);
    s16x4 vlo[8], vhi[8]; u32x4 pw0, pw1, pw2, pw3;
#define PKW(P, B) pk2(P[B], P[(B) + 1])
#define PAF(k) __builtin_bit_cast(bf16x8, pw##k)
#define VFR(i) (bf16x8){vlo[i][0], vlo[i][1], vlo[i][2], vlo[i][3], vhi[i][0], vhi[i][1], vhi[i][2], vhi[i][3]}
#define PIN(x) asm volatile("" : "+v"(x))
#define SBAR_() __builtin_amdgcn_sched_barrier(0)
#define GAPA(MF, A0, A1, A2, A3, W0, W1, PW) do { MF; sacc += A0; sacc += A1; sacc += A2; sacc += A3; PIN(sacc); W0; W1; PIN(PW); SBAR_(); } while (0)
#define EX_(v) __builtin_amdgcn_exp2f(v)
#define GAPB(MF, X, B) do { MF; X[B] = EX_(X[B]); X[(B) + 1] = EX_(X[(B) + 1]); X[(B) + 2] = EX_(X[(B) + 2]); X[(B) + 3] = EX_(X[(B) + 3]); PIN(X); SBAR_(); } while (0)
#define VRD(i) do { vlo[i] = vtr_(vp_ + (((i) >> 2) * 4096 + ((i) & 3) * 1024)); vhi[i] = vtr_(vp_ + (((i) >> 2) * 4096 + ((i) & 3) * 1024 + 512)); } while (0)
#define KRD(G, j) do { if (G) { KLOAD2(kp0 + sl_next, j); SBAR_(); } } while (0)
#define STEP(C0, C1, P0, P1, t, GK, GV, GL) do { SBAR_(); \
    const LAS unsigned char* vp_ = vp0 + sl_prev; \
    VRD(0); SBAR_(); float sacc = (P0[0] + P0[1]); \
    GAPA(C0 = MK_MFMA32(kf[0], qr[0], negm), P0[2], P0[3], P0[4], P0[5],     pw0[0] = PKW(P0, 0), pw0[1] = PKW(P0, 2), pw0); \
    VRD(4); SBAR_(); GAPA(C1 = MK_MFMA32(kf[1], qr[0], negm), P0[6], P0[7], P0[8], P0[9],     pw0[2] = PKW(P0, 4), pw0[3] = PKW(P0, 6), pw0); \
    VRD(1); SBAR_(); GAPA(C0 = MK_MFMA32(kf[2], qr[1], C0),   P0[10], P0[11], P0[12], P0[13], pw1[0] = PKW(P0, 8), pw1[1] = PKW(P0, 10), pw1); \
    VRD(5); SBAR_(); GAPA(C1 = MK_MFMA32(kf[3], qr[1], C1),   P0[14], P0[15], P1[0], P1[1],   pw1[2] = PKW(P0, 12), pw1[3] = PKW(P0, 14), pw1); \
    VRD(2); SBAR_(); GAPA(C0 = MK_MFMA32(kf[4], qr[2], C0),   P1[2], P1[3], P1[4], P1[5],     pw2[0] = PKW(P1, 0), pw2[1] = PKW(P1, 2), pw2); \
    VRD(6); SBAR_(); GAPA(C1 = MK_MFMA32(kf[5], qr[2], C1),   P1[6], P1[7], P1[8], P1[9],     pw2[2] = PKW(P1, 4), pw2[3] = PKW(P1, 6), pw2); \
    VRD(3); SBAR_(); GAPA(C0 = MK_MFMA32(kf[6], qr[3], C0),   P1[10], P1[11], P1[12], P1[13], pw3[0] = PKW(P1, 8), pw3[1] = PKW(P1, 10), pw3); \
    VRD(7); SBAR_(); GAPA(C1 = MK_MFMA32(kf[7], qr[3], C1),   P1[14], P1[15], 0.f, 0.f,       pw3[2] = PKW(P1, 12), pw3[3] = PKW(P1, 14), pw3); \
    l_reg += sacc; \
    if (GK) { DMA_K((t) + 3, sl_cur); } if (GV) { DMA_V((t) + 1, sl_next); } \
    SBAR_(); \
    GAPB(o0 = MK_MFMA32(VFR(0), PAF(0), o0), C0, 0); \
    GAPB(o1 = MK_MFMA32(VFR(4), PAF(0), o1), C0, 4); \
    KRD(GL, 0); GAPB(o0 = MK_MFMA32(VFR(1), PAF(1), o0), C0, 8); \
    KRD(GL, 1); GAPB(o1 = MK_MFMA32(VFR(5), PAF(1), o1), C0, 12); \
    KRD(GL, 2); GAPB(o0 = MK_MFMA32(VFR(2), PAF(2), o0), C1, 0); \
    KRD(GL, 3); GAPB(o1 = MK_MFMA32(VFR(6), PAF(2), o1), C1, 4); \
    GAPB(o0 = MK_MFMA32(VFR(3), PAF(3), o0), C1, 8); \
    GAPB(o1 = MK_MFMA32(VFR(7), PAF(3), o1), C1, 12); \
    } while (0)
    int t = 1;
    for (; t + 5 < NT; t += 2) {
        STEP(pB0, pB1, pA0, pA1, t, true, true, true);     MK_WAIT_BAR(2); ROT();
        STEP(pA0, pA1, pB0, pB1, t + 1, true, true, true); MK_WAIT_BAR(2); ROT();
    }
#define ENDW(tt) do { if ((tt) + 3 < NT) { MK_WAIT_BAR(2); } else if ((tt) + 2 < NT) { MK_WAIT_BAR(1); } else { MK_WAIT_BAR(0); } } while (0)
    for (; t + 1 < NT; t += 2) {
        STEP(pB0, pB1, pA0, pA1, t, (t + 3 < NT), (t + 1 < NT), (t + 1 < NT));         ENDW(t);     ROT();
        STEP(pA0, pA1, pB0, pB1, t + 1, (t + 4 < NT), (t + 2 < NT), (t + 2 < NT));     ENDW(t + 1); ROT();
    }
    STEP(pB0, pB1, pA0, pA1, NT - 1, false, false, false);
    {
        float sacc = pB0[0] + pB0[1];
#pragma unroll
        for (int r = 2; r < 16; ++r) sacc += pB0[r];
#pragma unroll
        for (int r = 0; r < 16; ++r) sacc += pB1[r];
        l_reg += sacc;
        const bf16x8 b0 = pack8(pB0, 0), b1 = pack8(pB0, 8), b2 = pack8(pB1, 0), b3 = pack8(pB1, 8);
        SBAR_();
        const unsigned vb = vb0u + (unsigned)sl_cur;
        pv_one<0>(o0, vb, b0, b1, b2, b3); pv_one<1>(o1, vb, b0, b1, b2, b3);
    }
#undef PKW
#undef PAF
#undef VFR
#undef PIN
#undef GAPA
#undef GAPB
#undef EX_
#undef VRD
#undef KRD
#undef STEP
#undef ENDW
#undef KLOAD2
#undef ROT
#undef DMA_K
#undef DMA_V
#undef MK_GROW0
    { const auto rr = __builtin_amdgcn_permlane32_swap(__float_as_uint(l_reg), __float_as_uint(l_reg), false, false); l_reg = __uint_as_float(rr[0]) + __uint_as_float(rr[1]); }
    const float inv = 1.f / l_reg;
    bf16* gp = (bf16*)(p.ws + WS_GATE) + (size_t)qrow * 1024 + 384 + h * 64 + 8 * hi;
#pragma unroll
    for (int tl = 0; tl < 2; ++tl)
#pragma unroll
        for (int pr = 0; pr < 2; ++pr) {
            const u32x4 gw = *(const u32x4*)(gp + 32 * tl + 16 * pr);
            float v[8];
#pragma unroll
            for (int e = 0; e < 4; ++e) {
                const float lo = tl ? o1[8 * pr + e] : o0[8 * pr + e], hi_ = tl ? o1[8 * pr + 4 + e] : o0[8 * pr + 4 + e];
                const auto rr = __builtin_amdgcn_permlane32_swap(__float_as_uint(lo), __float_as_uint(hi_), false, false);
                v[e] = __uint_as_float(rr[0]); v[4 + e] = __uint_as_float(rr[1]);
            }
            u32x4 ow;
            ow.x = pk2(v[0] * inv * siluf(lo_bf(gw.x)), v[1] * inv * siluf(hi_bf(gw.x))); ow.y = pk2(v[2] * inv * siluf(lo_bf(gw.y)), v[3] * inv * siluf(hi_bf(gw.y)));
            ow.z = pk2(v[4] * inv * siluf(lo_bf(gw.z)), v[5] * inv * siluf(hi_bf(gw.z))); ow.w = pk2(v[6] * inv * siluf(lo_bf(gw.w)), v[7] * inv * siluf(hi_bf(gw.w)));
            *(u32x4*)(gp + 32 * tl + 16 * pr) = ow;
        }
    asm volatile("s_waitcnt lgkmcnt(0)\n\ts_barrier" ::: "memory");
}
DI void attn_run_unit(const Ptrs& p, int l, LAS unsigned char* lds, int u, int tid) {
    bool mla, ctxq; int b, h, qb;
    if (u < 1536) { const int v = u < 768 ? u : u - 768; mla = u < 768; ctxq = false; b = v / 48; h = (v % 48) / 8; qb = v % 8; }
    else { const int v = u - 1536, w = v % 96; mla = v < 96; ctxq = true; b = w / 6; h = w % 6; qb = 0; }
    if (mla) attn_unit<true>(p, l, lds, b, h, qb, ctxq, tid);
    else attn_unit_g(p, l, lds, b, h, qb, ctxq, tid);
}
DI int attn_list_len(int l) { return 192 + (l == 0 ? 24 : 0); }
DI void attn_run_list_unit(const Ptrs& p, int l, LAS unsigned char* lds, int x, int j, int tid) {
    if (j < 192) { const int ty = j / 96, jj = j % 96, pr = x + 8 * (jj >> 3), qb = jj & 7;
        if (ty == 0) attn_unit<true>(p, l, lds, pr / 6, pr % 6, qb, false, tid); else attn_unit<false>(p, l, lds, pr / 6, pr % 6, qb, false, tid); }
    else { const int jj = j - 192, ty = jj / 12, pr = x + 8 * (jj % 12);
        if (ty == 0) attn_unit<true>(p, l, lds, pr / 6, pr % 6, 0, true, tid); else attn_unit<false>(p, l, lds, pr / 6, pr % 6, 0, true, tid); }
}
DI void p4_attention(const Ptrs& p, int l, LAS unsigned char* lds, int wg, int nwg, int tid) {
    const int nunits = 1536 + (l == 0 ? 192 : 0);
    for (int u = wg; u < nunits; u += nwg) {
        if (u < 768) attn_unit<true>(p, l, lds, u / 48, (u % 48) / 8, u % 8, false, tid);
        else if (u < 1536) { const int v = u - 768; attn_unit<false>(p, l, lds, v / 48, (v % 48) / 8, v % 8, false, tid); }
        else { const int v = u - 1536, w = v % 96; if (v < 96) attn_unit<true>(p, l, lds, w / 6, w % 6, 0, true, tid); else attn_unit<false>(p, l, lds, w / 6, w % 6, 0, true, tid); }
    }
}
}
namespace mk {
constexpr size_t GI_ITEM = 67584, GI_QF = 0, GI_KTF = 8192, GI_DIR = 16384, GI_DIRSZ = 25600, GI_WF = 0, GI_AF = 8192, GI_UC = 16384, GI_VEC = 24576;
DI int gdn_row0(int b, int ci) { return ci < 4 ? NLAT + b * 256 + ci * 64 : b * 2048 + (ci - 4) * 64; }
typedef float f32x4v __attribute__((ext_vector_type(4)));
#define MK_MFMA16(a, b, c) __builtin_amdgcn_mfma_f32_16x16x32_bf16((a), (b), (c), 0, 0, 0)

constexpr int PL_KB = 0, PL_KBT = 9216, PL_QB = 18432, PL_VT = 27648, PL_G = 36864, PL_QK = 53504, PL_NS = 70144, PL_TB = 102912, PL_VEC = 139776;

#ifndef MK_TSI
#define MK_TSI(tag) do { } while (0)
#endif
struct PrepPf { u32x4 r[5]; float bb, aa; };
constexpr int PL_WL = 141824;
DI void gdn_prep_item(const Ptrs& p, int l, LAS unsigned char* lds, int b, int ci, int head, int tid, PrepPf& pf, bool first, bool has_next, int nb_, int nci_) {
    asm volatile("" : "+v"(tid));
    const int wave = tid >> 6, lane = tid & 63;
    const int R0 = gdn_row0(b, ci);
    const int t0 = ci < 4 ? ci * 64 : (ci - 4) * 64, slen = ci < 4 ? 256 : 2048;
    unsigned char* gi = p.ws + WS_GDNI + (size_t)((b * 36 + ci) * 4 + head) * GI_ITEM;
    const bf16* GDN = (const bf16*)(p.ws + WS_GDN);
    LAS bf16* Kb = (LAS bf16*)(lds + PL_KB); LAS bf16* KbT = (LAS bf16*)(lds + PL_KBT); LAS bf16* Qb = (LAS bf16*)(lds + PL_QB); LAS bf16* VT = (LAS bf16*)(lds + PL_VT);
    LAS float* Gm = (LAS float*)(lds + PL_G); LAS float* QKm = (LAS float*)(lds + PL_QK);
    MK_TSI(16);
    {
        LAS unsigned char* raw = lds + PL_NS;
        if (first) {
            for (int e = tid; e < 68 * 24; e += NT) {
                const int r = e / 24, q = e % 24, part = q >> 3, ch8 = q & 7, ts = t0 - 2 + r;
                u32x4 v = {0u, 0u, 0u, 0u};
                if (ts >= 0 && ts < slen) v = *(const u32x4*)(GDN + (size_t)(R0 - 2 + r) * 768 + part * 256 + head * 64 + ch8 * 8);
                *(LAS u32x4*)(raw + r * 400 + part * 128 + ch8 * 16) = v;
            }
            LAS float* wl = (LAS float*)(lds + PL_WL);
            for (int e = tid; e < 960; e += NT) { const int part = e / 320, j = (e % 320) >> 6, cc = e & 63; wl[e] = p.gdn_conv_w[(size_t)l * 5 * 768 + j * 768 + part * 256 + head * 64 + cc]; }
        } else if (wave >= 2) {
#pragma unroll
            for (int k = 0; k < 5; ++k) { const int e = tid - 128 + 384 * k; if (e < 68 * 24) { const int r = e / 24, q = e % 24; *(LAS u32x4*)(raw + r * 400 + (q >> 3) * 128 + (q & 7) * 16) = pf.r[k]; } }
        }
    }
    __syncthreads();
    MK_TSI(17);
    {
        const int t = tid >> 3, c8 = tid & 7;
        const LAS unsigned char* raw = lds + PL_NS + t * 400 + c8 * 16;
        const LAS float* wl = (const LAS float*)(lds + PL_WL) + c8 * 8;
#pragma unroll
        for (int part = 0; part < 3; ++part) {
            float acc[8];
#pragma unroll
            for (int i = 0; i < 8; ++i) acc[i] = 0.f;
#pragma unroll
            for (int j = 0; j < 5; ++j) {
                const u32x4 x = *(const LAS u32x4*)(raw + j * 400 + part * 128);
                const f32x4v w0 = *(const LAS f32x4v*)(wl + part * 320 + j * 64), w1 = *(const LAS f32x4v*)(wl + part * 320 + j * 64 + 4);
                acc[0] += lo_bf(x.x) * w0.x; acc[1] += hi_bf(x.x) * w0.y; acc[2] += lo_bf(x.y) * w0.z; acc[3] += hi_bf(x.y) * w0.w;
                acc[4] += lo_bf(x.z) * w1.x; acc[5] += hi_bf(x.z) * w1.y; acc[6] += lo_bf(x.w) * w1.z; acc[7] += hi_bf(x.w) * w1.w;
            }
            float ss = 0.f;
#pragma unroll
            for (int i = 0; i < 8; ++i) { acc[i] = acc[i] / (1.f + __expf(-acc[i])); ss += acc[i] * acc[i]; }
            if (part < 2) {
                ss += __builtin_bit_cast(float, __builtin_amdgcn_update_dpp(0, __builtin_bit_cast(int, ss), 0xB1, 0xF, 0xF, false));
                ss += __builtin_bit_cast(float, __builtin_amdgcn_update_dpp(0, __builtin_bit_cast(int, ss), 0x4E, 0xF, 0xF, false));
                ss += __builtin_bit_cast(float, __builtin_amdgcn_update_dpp(0, __builtin_bit_cast(int, ss), 0x141, 0xF, 0xF, false));
                const float rn = (part == 0 ? 0.125f : 1.f) / sqrtf(ss + EPS);
#pragma unroll
                for (int i = 0; i < 8; ++i) acc[i] *= rn;
            }
            u32x4 w; w.x = pk2(acc[0], acc[1]); w.y = pk2(acc[2], acc[3]); w.z = pk2(acc[4], acc[5]); w.w = pk2(acc[6], acc[7]);
            if (part == 0) *(LAS u32x4*)(Qb + t * 72 + c8 * 8) = w;
            else {
                if (part == 1) *(LAS u32x4*)(Kb + t * 72 + c8 * 8) = w;
                LAS bf16* tp = (part == 1 ? KbT : VT) + (c8 * 8) * 72 + t;
                tp[0 * 72] = (bf16)(w.x & 0xffffu); tp[1 * 72] = (bf16)(w.x >> 16); tp[2 * 72] = (bf16)(w.y & 0xffffu); tp[3 * 72] = (bf16)(w.y >> 16);
                tp[4 * 72] = (bf16)(w.z & 0xffffu); tp[5 * 72] = (bf16)(w.z >> 16); tp[6 * 72] = (bf16)(w.w & 0xffffu); tp[7 * 72] = (bf16)(w.w >> 16);
            }
        }
    }
    MK_TSI(18);
    if (wave >= 6) {
        const int d = wave - 6;
        const float* ba = (const float*)(p.ws + WS_BA) + (size_t)(R0 + lane) * 16;
        const float bbv = first ? ba[d * 4 + head] : pf.bb, aav = first ? ba[8 + d * 4 + head] : pf.aa;
        const float beta = 1.f / (1.f + __expf(-bbv));
        const float xa = aav + p.gdn_dt_bias[l * 8 + d * 4 + head];
        const float ex = __expf(xa);
        const float sp = xa > 20.f ? xa : (ex < 0.03f ? ex * (1.f - ex * (0.5f - ex * 0.33333334f)) : __logf(1.f + ex));
        const float g = -__expf(p.gdn_a_log[l * 8 + d * 4 + head]) * sp;
        float c = g;
#pragma unroll
        for (int o = 1; o < 64; o <<= 1) { const float nb = shl_(c, d == 0 ? (lane - o) & 63 : (lane + o) & 63, lane); const bool ok = d == 0 ? (lane >= o) : (lane + o < 64); c += ok ? nb : 0.f; }
        const float clast = shl_(c, d == 0 ? 63 : 0, lane);
        LAS float* vec = (LAS float*)(lds + PL_VEC + d * 1024);
        vec[lane] = c; vec[64 + lane] = beta; vec[128 + lane] = __expf(c); vec[192 + lane] = __expf(clast - c);
        float* gv = (float*)(gi + GI_DIR + d * GI_DIRSZ + GI_VEC);
        gv[lane] = __expf(c); gv[64 + lane] = __expf(clast - c); if (lane == 0) gv[128] = __expf(clast);
    }
    __syncthreads();
    MK_TSI(19);
    {
        const int prod = wave >> 2, tt = (wave >> 1) & 1, st = wave & 1, r32 = lane & 31, hh = lane >> 5;
        const LAS bf16* Am = prod == 0 ? Kb : Qb;
        f32x16 acc = {};
#pragma unroll
        for (int s = 0; s < 4; ++s) {
            const bf16x8 a = *(const LAS bf16x8*)(Am + (32 * tt + r32) * 72 + 16 * s + 8 * hh);
            const bf16x8 bb = *(const LAS bf16x8*)(Kb + (32 * st + r32) * 72 + 16 * s + 8 * hh);
            acc = MK_MFMA32(a, bb, acc);
        }
        LAS float* Om = prod == 0 ? Gm : QKm;
#pragma unroll
        for (int r = 0; r < 16; ++r) Om[(32 * tt + (r & 3) + 8 * (r >> 2) + 4 * hh) * 65 + 32 * st + r32] = acc[r];
    }
    __syncthreads();
    MK_TSI(20);
    {
        const int d = tid >> 8, lt = tid & 255;
        const LAS float* vec = (const LAS float*)(lds + PL_VEC + d * 1024);
        LAS float* Ns = (LAS float*)(lds + PL_NS + d * 16384);
        for (int e = lt; e < 4096; e += 256) {
            const int i2 = e >> 6, i = e & 63, t = d ? 63 - i : i, t2 = d ? 63 - i2 : i2;
            Ns[i2 * 64 + i] = i2 < i ? vec[64 + t] * Gm[t * 65 + t2] * __expf(vec[t] - vec[t2]) : 0.f;
        }
    }
    __syncthreads();
    MK_TSI(21);
    if (wave < 2) {
        const int d = wave;
        const LAS float* Ns = (const LAS float*)(lds + PL_NS + d * 16384);
        const LAS float* vec = (const LAS float*)(lds + PL_VEC + d * 1024);
        f32x2 Tp[32];
#pragma unroll
        for (int i = 0; i < 32; ++i) Tp[i] = (f32x2){(2 * i == lane) ? 1.f : 0.f, (2 * i + 1 == lane) ? 1.f : 0.f};
        f32x4v nva[16], nvb[16];
#pragma unroll
        for (int i4 = 0; i4 < 16; ++i4) nva[i4] = *(const LAS f32x4v*)(Ns + 4 * i4);
#define MK_SOLVE_STEP(j, CUR, NXT) do { \
            if ((j) + 1 < 63) { _Pragma("unroll") for (int i4 = ((j) + 2) / 4; i4 < 16; ++i4) NXT[i4] = *(const LAS f32x4v*)(Ns + ((j) + 1) * 64 + 4 * i4); } \
            const float tj = ((j) & 1) ? Tp[(j) >> 1].y : Tp[(j) >> 1].x; const f32x2 tj2 = {tj, tj}; \
            _Pragma("unroll") for (int i4 = ((j) + 1) / 4; i4 < 16; ++i4) { \
                Tp[2 * i4] -= (f32x2){CUR[i4].x, CUR[i4].y} * tj2; Tp[2 * i4 + 1] -= (f32x2){CUR[i4].z, CUR[i4].w} * tj2; } \
            __builtin_amdgcn_sched_barrier(0); } while (0)
#pragma unroll
        for (int j = 0; j < 62; j += 2) { MK_SOLVE_STEP(j, nva, nvb); MK_SOLVE_STEP(j + 1, nvb, nva); }
        MK_SOLVE_STEP(62, nva, nvb);
#undef MK_SOLVE_STEP
        const int sc = d ? 63 - lane : lane;
        const float bs = vec[64 + sc], bc = bs * vec[128 + sc];
        LAS bf16* Tb = (LAS bf16*)(lds + PL_TB + d * 18432); LAS bf16* Tc = Tb + 4608;
#pragma unroll
        for (int i = 0; i < 64; ++i) { const int t = d ? 63 - i : i; const float ti = (i & 1) ? Tp[i >> 1].y : Tp[i >> 1].x; Tb[t * 72 + sc] = (bf16)f2bf(ti * bs); Tc[t * 72 + sc] = (bf16)f2bf(ti * bc); }
    } else {
        const int ew = wave - 2;
        for (int e = ew * 64 + lane; e < 1024; e += 384) {
            const int which = e >> 9, f = (e >> 6) & 7, ln = e & 63, mt = f >> 1, ks = f & 1, r = ln & 15, g = ln >> 4;
            const LAS bf16* src = (which == 0 ? Qb : KbT) + (16 * mt + r) * 72 + 32 * ks + 4 * g;
            const u32x2 lo = *(const LAS u32x2*)src, hi = *(const LAS u32x2*)(src + 16);
            *(u32x4*)(gi + (which == 0 ? GI_QF : GI_KTF) + (size_t)f * 1024 + ln * 16) = (u32x4){lo.x, lo.y, hi.x, hi.y};
        }
        for (int e = ew * 64 + lane; e < 1024; e += 384) {
            const int d = e >> 9, f = (e >> 6) & 7, ln = e & 63, mt = f >> 1, ks = f & 1, r = ln & 15, g = ln >> 4, t = 16 * mt + r;
            const LAS float* vec = (const LAS float*)(lds + PL_VEC + d * 1024);
            const float ct = vec[t];
            float v[8];
#pragma unroll
            for (int j = 0; j < 8; ++j) { const int s = 32 * ks + (j < 4 ? 4 * g + j : 16 + 4 * g + (j - 4)); const bool ok = d ? (s >= t) : (s <= t); v[j] = ok ? QKm[t * 65 + s] * __expf(ct - vec[s]) : 0.f; }
            u32x4 w; w.x = pk2(v[0], v[1]); w.y = pk2(v[2], v[3]); w.z = pk2(v[4], v[5]); w.w = pk2(v[6], v[7]);
            *(u32x4*)(gi + GI_DIR + d * GI_DIRSZ + GI_AF + (size_t)f * 1024 + ln * 16) = w;
        }
        if (has_next) {
            const int nR0 = gdn_row0(nb_, nci_), nt0 = nci_ < 4 ? nci_ * 64 : (nci_ - 4) * 64, nslen = nci_ < 4 ? 256 : 2048;
#pragma unroll
            for (int k = 0; k < 5; ++k) { const int e = tid - 128 + 384 * k; u32x4 v = {0u, 0u, 0u, 0u};
                if (e < 68 * 24) { const int r = e / 24, q = e % 24, ts = nt0 - 2 + r; if (ts >= 0 && ts < nslen) v = *(const u32x4*)(GDN + (size_t)(nR0 - 2 + r) * 768 + (q >> 3) * 256 + head * 64 + (q & 7) * 8); }
                pf.r[k] = v; }
            if (wave >= 6) { const int d = wave - 6; const float* nba = (const float*)(p.ws + WS_BA) + (size_t)(nR0 + lane) * 16; pf.bb = nba[d * 4 + head]; pf.aa = nba[8 + d * 4 + head]; }
        }
    }
    __syncthreads();
    MK_TSI(22);
    {
        const int d = wave >> 2, r32 = lane & 31, hh = lane >> 5;
        const LAS bf16* Tb = (const LAS bf16*)(lds + PL_TB + d * 18432); const LAS bf16* Tc = Tb + 4608;
        LAS bf16* uT = (LAS bf16*)(lds + PL_G + d * 16640); LAS bf16* Wb = (LAS bf16*)(lds + PL_NS + d * 16384);
#pragma unroll
        for (int q = 0; q < 2; ++q) {
            const int task = (wave & 3) * 2 + q, isw = task >> 2, ta = (task >> 1) & 1, tb2 = task & 1;
            const LAS bf16* Ap = (isw ? KbT : Tb) + (32 * ta + r32) * 72 + 8 * hh;
            const LAS bf16* Bp = (isw ? Tc : VT) + (32 * tb2 + r32) * 72 + 8 * hh;
            f32x16 acc = {};
#pragma unroll
            for (int s = 0; s < 4; ++s) acc = MK_MFMA32(*(const LAS bf16x8*)(Ap + 16 * s), *(const LAS bf16x8*)(Bp + 16 * s), acc);
            LAS bf16* Op = (isw ? Wb : uT) + (32 * tb2 + r32) * 72 + 32 * ta + 4 * hh;
#pragma unroll
            for (int g4 = 0; g4 < 4; ++g4) { u32x2 w; w.x = pk2(acc[4 * g4], acc[4 * g4 + 1]); w.y = pk2(acc[4 * g4 + 2], acc[4 * g4 + 3]); *(LAS u32x2*)(Op + 8 * g4) = w; }
        }
    }
    __syncthreads();
    MK_TSI(23);
    {
        const int d = tid >> 8, lt = tid & 255;
        const LAS bf16* uT = (const LAS bf16*)(lds + PL_G + d * 16640); const LAS bf16* Wb = (const LAS bf16*)(lds + PL_NS + d * 16384);
        unsigned char* gd = gi + GI_DIR + d * GI_DIRSZ;
        for (int e = lt; e < 512; e += 256) {
            const int f = e >> 6, ln = e & 63, mt = f >> 1, ks = f & 1, r = ln & 15, g = ln >> 4;
            const LAS bf16* src = Wb + (16 * mt + r) * 72 + 32 * ks + 4 * g;
            const u32x2 lo = *(const LAS u32x2*)src, hi = *(const LAS u32x2*)(src + 16);
            *(u32x4*)(gd + GI_WF + (size_t)f * 1024 + ln * 16) = (u32x4){lo.x, lo.y, hi.x, hi.y};
        }
        for (int e = lt; e < 1024; e += 256) {
            const int f = e >> 6, ln = e & 63, wv = f >> 2, mt = f & 3, c = ln & 15, g = ln >> 4;
            *(u32x2*)(gd + GI_UC + (size_t)f * 512 + ln * 8) = *(const LAS u32x2*)(uT + (16 * wv + c) * 72 + 16 * mt + 4 * g);
        }
    }
    __syncthreads();
    MK_TSI(24);
}

constexpr int SC_QF = 0, SC_KTF = 8192, SC_WF = 16384, SC_AF = 24576, SC_UC = 32768, SC_VEC = 40960, SC_BUF = 41984;
DI int scan_ci(int step, int d) { return step < 4 ? (d ? 3 - step : step) : 4 + (d ? 35 - step : step - 4); }
DI void gdn_scan_chain(const Ptrs& p, LAS unsigned char* lds, size_t of_off, size_t ob_off, int b, int head, int d, int tid) {
    asm volatile("" : "+v"(tid));
    const int wave = __builtin_amdgcn_readfirstlane(tid >> 6), lane = tid & 63;
    const unsigned char* gbase = p.ws + WS_GDNI + (size_t)(b * 36 * 4 + head) * GI_ITEM;
    __syncthreads();
    if (wave >= 4) {
        const int lw = wave - 4;
#define MK_SC_ISSUE(step) do { const int _ci = scan_ci((step), d); const unsigned char* _gi = gbase + (size_t)_ci * 4 * GI_ITEM; const unsigned char* _gd = _gi + GI_DIR + d * GI_DIRSZ; \
        LAS unsigned char* _buf = lds + ((step) % 3) * SC_BUF; \
        _Pragma("unroll") for (int _k = 0; _k < 11; ++_k) { int _p = lw + 4 * _k; if (_p > 40) _p = lw; \
            const unsigned char* _src = (_p < 16 ? _gi + (size_t)_p * 1024 : _gd + (size_t)(_p - 16) * 1024) + lane * 16; \
            __builtin_amdgcn_global_load_lds((const unsigned*)_src, (LAS unsigned*)(_buf + _p * 1024), 16, 0, 0); } } while (0)
        MK_SC_ISSUE(0); MK_SC_ISSUE(1);
        for (int s = 0; s < 36; ++s) {
            if (s + 1 < 36) asm volatile("s_waitcnt vmcnt(11)" ::: "memory"); else asm volatile("s_waitcnt vmcnt(0)" ::: "memory");
            asm volatile("" ::: "memory"); __builtin_amdgcn_s_barrier(); asm volatile("" ::: "memory");
            if (s + 2 < 36) MK_SC_ISSUE(s + 2);
        }
#undef MK_SC_ISSUE
    } else {
        const int wv = wave, c = lane & 15, g = lane >> 4;
        bf16* O = (bf16*)(p.ws + (d ? ob_off : of_off));
        f32x4v S[4];
#pragma unroll
        for (int i = 0; i < 4; ++i) S[i] = (f32x4v){0.f, 0.f, 0.f, 0.f};
        for (int step = 0; step < 36; ++step) {
            asm volatile("" ::: "memory"); __builtin_amdgcn_s_barrier(); asm volatile("" ::: "memory");
            __builtin_amdgcn_sched_barrier(0);
            const LAS unsigned char* buf = lds + (step % 3) * SC_BUF;
            const LAS float* vec = (const LAS float*)(buf + SC_VEC);
            const float gl = vec[128];
            bf16x8 Sb[2];
#pragma unroll
            for (int ks = 0; ks < 2; ++ks) { u32x4 w; w.x = pk2(S[2 * ks][0], S[2 * ks][1]); w.y = pk2(S[2 * ks][2], S[2 * ks][3]); w.z = pk2(S[2 * ks + 1][0], S[2 * ks + 1][1]); w.w = pk2(S[2 * ks + 1][2], S[2 * ks + 1][3]); Sb[ks] = __builtin_bit_cast(bf16x8, w); }
            f32x4v vn[4], o[4];
            const LAS bf16x8* wF = (const LAS bf16x8*)(buf + SC_WF) + lane; const LAS bf16x8* qF = (const LAS bf16x8*)(buf + SC_QF) + lane;
            const LAS bf16x8* aF = (const LAS bf16x8*)(buf + SC_AF) + lane; const LAS bf16x8* kF = (const LAS bf16x8*)(buf + SC_KTF) + lane;
#pragma unroll
            for (int mt = 0; mt < 4; ++mt) {
                f32x4v ws = {0.f, 0.f, 0.f, 0.f}, qs = {0.f, 0.f, 0.f, 0.f};
#pragma unroll
                for (int ks = 0; ks < 2; ++ks) { ws = MK_MFMA16(wF[(2 * mt + ks) * 64], Sb[ks], ws); qs = MK_MFMA16(qF[(2 * mt + ks) * 64], Sb[ks], qs); }
                const u32x2 uu = *(const LAS u32x2*)(buf + SC_UC + (wv * 4 + mt) * 512 + lane * 8);
                const f32x4v ec = *(const LAS f32x4v*)(vec + 16 * mt + 4 * g);
                vn[mt] = (f32x4v){lo_bf(uu.x) - ws[0], hi_bf(uu.x) - ws[1], lo_bf(uu.y) - ws[2], hi_bf(uu.y) - ws[3]};
                o[mt] = ec * qs;
            }
            bf16x8 Vb[2], Vb2[2];
#pragma unroll
            for (int ks = 0; ks < 2; ++ks) {
                const f32x4v e0 = *(const LAS f32x4v*)(vec + 64 + 16 * (2 * ks) + 4 * g), e1 = *(const LAS f32x4v*)(vec + 64 + 16 * (2 * ks + 1) + 4 * g);
                const f32x4v a0 = vn[2 * ks], a1 = vn[2 * ks + 1], b0 = a0 * e0, b1 = a1 * e1;
                u32x4 w; w.x = pk2(a0[0], a0[1]); w.y = pk2(a0[2], a0[3]); w.z = pk2(a1[0], a1[1]); w.w = pk2(a1[2], a1[3]); Vb[ks] = __builtin_bit_cast(bf16x8, w);
                u32x4 w2; w2.x = pk2(b0[0], b0[1]); w2.y = pk2(b0[2], b0[3]); w2.z = pk2(b1[0], b1[1]); w2.w = pk2(b1[2], b1[3]); Vb2[ks] = __builtin_bit_cast(bf16x8, w2);
            }
            const int R0 = gdn_row0(b, scan_ci(step, d));
#pragma unroll
            for (int mt = 0; mt < 4; ++mt) {
                f32x4v oo = o[mt];
#pragma unroll
                for (int ks = 0; ks < 2; ++ks) oo = MK_MFMA16(aF[(2 * mt + ks) * 64], Vb[ks], oo);
                bf16* op = O + (size_t)(R0 + 16 * mt + 4 * g) * 256 + head * 64 + 16 * wv + c;
#pragma unroll
                for (int i = 0; i < 4; ++i) op[(size_t)i * 256] = (bf16)f2bf(oo[i]);
            }
#pragma unroll
            for (int dt = 0; dt < 4; ++dt) {
                f32x4v sn = S[dt] * gl;
#pragma unroll
                for (int ks = 0; ks < 2; ++ks) sn = MK_MFMA16(kF[(2 * dt + ks) * 64], Vb2[ks], sn);
                S[dt] = sn;
            }
            asm volatile("s_waitcnt lgkmcnt(0)" ::: "memory");
        }
    }
    __syncthreads();
}
DI void p3_gdnprep(const Ptrs& p, int l, LAS unsigned char* lds, int wg, int nwg, int tid, int nb) {
    PrepPf pf;
#pragma unroll
    for (int k = 0; k < 5; ++k) pf.r[k] = (u32x4){0u, 0u, 0u, 0u};
    pf.bb = 0.f; pf.aa = 0.f;
    const bool samehead = (nwg & 3) == 0;
    bool first = true;
    for (int it = wg; it < nb * 144; it += nwg) {
        const int nx = it + nwg; const bool has_next = samehead && nx < nb * 144;
        gdn_prep_item(p, l, lds, it / 144, (it % 144) >> 2, it & 3, tid, pf, first, has_next, nx / 144, (nx % 144) >> 2);
        first = !samehead;
    }
}
DI void p4_gdnscan(const Ptrs& p, LAS unsigned char* lds, size_t of_off, size_t ob_off, int wg, int nwg, int tid, int nb) {
    for (int ch = wg; ch < nb * 8; ch += nwg) gdn_scan_chain(p, lds, of_off, ob_off, ch >> 3, (ch >> 1) & 3, ch & 1, tid);
}
}
namespace mk {
DI void p5_gdn_combine(const Ptrs& p, int l, int nrows, int gw, int ngw, int lane) {
    const bf16* OF = (const bf16*)(p.ws + WS_CQ); const bf16* OB = (const bf16*)(p.ws + WS_CKV); bf16* G = (bf16*)(p.ws + WS_GATE);
    const f32x4 og = *(const f32x4*)(p.gdn_on_g + l * 64 + (lane & 15) * 4);
    for (int Rb = gw; Rb < nrows; Rb += 4 * ngw) {
        u32x2 a4[4], b4[4], g4[4];
#pragma unroll
        for (int k = 0; k < 4; ++k) { const int R = Rb + k * ngw < nrows ? Rb + k * ngw : Rb;
            a4[k] = *(const u32x2*)(OF + (size_t)R * 256 + lane * 4); b4[k] = *(const u32x2*)(OB + (size_t)R * 256 + lane * 4); g4[k] = *(const u32x2*)(G + (size_t)R * 1024 + 768 + lane * 4); }
#pragma unroll
        for (int k = 0; k < 4; ++k) {
            const int R = Rb + k * ngw;
            if (R >= nrows) break;
            const u32x2 a = a4[k], bq = b4[k];
            const float o0 = lo_bf(a.x) + lo_bf(bq.x), o1 = hi_bf(a.x) + hi_bf(bq.x), o2 = lo_bf(a.y) + lo_bf(bq.y), o3 = hi_bf(a.y) + hi_bf(bq.y);
            float ss = o0 * o0 + o1 * o1 + o2 * o2 + o3 * o3;
            ss += shx(ss, 1, lane); ss += shx(ss, 2, lane); ss += shx(ss, 4, lane); ss += shx(ss, 8, lane);
            const float rstd = 1.f / sqrtf(ss * (1.f / 64.f) + EPS);
            bf16* gp = G + (size_t)R * 1024 + 768 + lane * 4;
            u32x2 gw2 = g4[k];
            gw2.x = pk2(o0 * rstd * og.x * siluf(lo_bf(gw2.x)), o1 * rstd * og.y * siluf(hi_bf(gw2.x)));
            gw2.y = pk2(o2 * rstd * og.z * siluf(lo_bf(gw2.y)), o3 * rstd * og.w * siluf(hi_bf(gw2.y)));
            *(u32x2*)gp = gw2;
        }
    }
}
struct EpiY {
    static constexpr bool PERM = true, AFTER_DRAIN = false;
    bf16* Y; const float* mod_l;
    DI void operator()(const pg8::f32x4 (&acc)[2][2][4][2], const pg8::Unit& u, int wr, int wc, int fr, int fq) const {
        const int row0 = u.pm * 256 + wr * 64 + fr;
        const float* gt = mod_l + (size_t)(u.pm >= NLAT / 256 ? 16 : (u.pm >> 3)) * 3072 + 2048;
#pragma unroll
        for (int bj = 0; bj < 2; ++bj) {
            const int c = 256 * u.pn + 128 * bj + 32 * wc + 8 * fq;
            const pg8::f32x4 g0 = *(const pg8::f32x4*)(gt + c), g1 = *(const pg8::f32x4*)(gt + c + 4);
#pragma unroll
            for (int ai = 0; ai < 2; ++ai)
#pragma unroll
                for (int m = 0; m < 4; ++m) { const int row = row0 + ai * 128 + m * 16;
                    const pg8::f32x4 v0 = acc[ai][bj][m][0] * g0, v1 = acc[ai][bj][m][1] * g1;
                    u32x4 w; w.x = pk2(v0[0], v0[1]); w.y = pk2(v0[2], v0[3]); w.z = pk2(v1[0], v1[1]); w.w = pk2(v1[2], v1[3]);
                    *(u32x4*)(Y + (size_t)row * 1024 + c) = w; }
        }
    }
};
DI void p7_final(const Ptrs& p, int gw, int ngw, int lane) {
    const bf16* Y = (const bf16*)(p.ws + WS_H);
    const int rpw = (NLAT + ngw - 1) / ngw, rbeg = gw * rpw, rend = rbeg + rpw < NLAT ? rbeg + rpw : NLAT;
    f32x4 g[4];
#pragma unroll
    for (int j = 0; j < 4; ++j) g[j] = *(const f32x4*)(p.final_g + lane * 4 + 256 * j);
    f32x4 v0[4], v1[4]; u32x2 y0[4], y1[4];
#define MK_P7_LOAD(R_, A0, A1, Y0, Y1) do { const int _R = (R_), _R1 = _R + 1 < rend ? _R + 1 : _R; \
        _Pragma("unroll") for (int j = 0; j < 4; ++j) { A0[j] = *(const f32x4*)(p.out + (size_t)_R * 1024 + lane * 4 + 256 * j); A1[j] = *(const f32x4*)(p.out + (size_t)_R1 * 1024 + lane * 4 + 256 * j); \
            Y0[j] = *(const u32x2*)(Y + (size_t)_R * 1024 + lane * 4 + 256 * j); Y1[j] = *(const u32x2*)(Y + (size_t)_R1 * 1024 + lane * 4 + 256 * j); } } while (0)
    if (rbeg < rend) MK_P7_LOAD(rbeg, v0, v1, y0, y1);
    for (int R = rbeg; R < rend; R += 2) {
        const bool two = R + 1 < rend; const int R1 = two ? R + 1 : R;
        const bool more = R + 2 < rend;
        f32x4 n0[4], n1[4]; u32x2 ny0[4], ny1[4];
        if (more) MK_P7_LOAD(R + 2, n0, n1, ny0, ny1);
#pragma unroll
        for (int rr = 0; rr < 2; ++rr) {
            if (rr == 1 && !two) break;
            float ss = 0.f; f32x4 x[4];
#pragma unroll
            for (int j = 0; j < 4; ++j) { const f32x4 v = rr ? v1[j] : v0[j]; const u32x2 y = rr ? y1[j] : y0[j];
                x[j] = (f32x4){v.x + __builtin_bit_cast(float, y.x << 16), v.y + __builtin_bit_cast(float, y.x & 0xffff0000u), v.z + __builtin_bit_cast(float, y.y << 16), v.w + __builtin_bit_cast(float, y.y & 0xffff0000u)};
                ss += (x[j].x * x[j].x + x[j].y * x[j].y) + (x[j].z * x[j].z + x[j].w * x[j].w); }
            ss = wave_sum(ss, lane);
            const float rstd = 1.f / sqrtf(ss * (1.f / 1024.f) + EPS);
            float* xr = p.out + (size_t)(rr ? R1 : R) * 1024;
#pragma unroll
            for (int j = 0; j < 4; ++j) *(f32x4*)(xr + lane * 4 + 256 * j) = (f32x4){x[j].x * rstd * g[j].x, x[j].y * rstd * g[j].y, x[j].z * rstd * g[j].z, x[j].w * rstd * g[j].w};
        }
        if (more) {
#pragma unroll
            for (int j = 0; j < 4; ++j) { v0[j] = n0[j]; v1[j] = n1[j]; y0[j] = ny0[j]; y1[j] = ny1[j]; }
        }
    }
#undef MK_P7_LOAD
}
}
#ifndef MK_PG8_ALIGN
#define MK_PG8_ALIGN true
#endif
#ifndef MK_PG8_SP2
#define MK_PG8_SP2 true
#endif
namespace mk {
struct InOrderL1 {
    pg8::StaticOrder lat; int G, c;
    DI bool next(int i, pg8::Unit& u) const {
        const int nlat = (NLAT / 256) * (NIN_PAD / 256);
        const long L = (long)i * G + c;
        if (L < nlat) return lat.next(i, u);
        const int idx = (int)(L - nlat); if (idx >= (NCTX / 256) * 7) return false;
        const int k = idx % 7; u.pm = NLAT / 256 + idx / 7; u.pn = k == 0 ? 1 : (k == 1 ? 2 : (k == 6 ? 12 : k + 2)); return true;
    }
    DI void a_ready(const pg8::Unit&) const {}
    DI void done(const pg8::Unit&) const {}
};
DI int mk_lane_volatile() { int ln; asm volatile("v_mbcnt_lo_u32_b32 %0, -1, 0\n\tv_mbcnt_hi_u32_b32 %0, -1, %0" : "=v"(ln)); return ln; }
struct KArgs { Ptrs p; int ph_lo, ph_hi; };
constexpr int PH_FINAL = 11, N_PHASES = 12;
#ifndef MK_COOP
#define MK_COOP 0
#endif
__global__ void __launch_bounds__(NT, 2) mega(KArgs a) {
    extern __shared__ __attribute__((aligned(16))) unsigned char lds_raw[];
    LAS unsigned char* lds = (LAS unsigned char*)lds_raw;
    volatile LAS unsigned* misc = (volatile LAS unsigned*)(lds + LDS_BYTES - 256);
    const int wave_s = __builtin_amdgcn_readfirstlane((int)threadIdx.x >> 6);
#define MK_TID() (wave_s * 64 + mk_lane_volatile())
    if (MK_TID() < 64) misc[MK_TID()] = 0u;
    __syncthreads();
    unsigned* ctl = (unsigned*)(a.p.ws + WS_CTL);
    XcdBarrier bar = xcd_barrier_post(ctl + 8192, misc + 8, MK_TID());
    const int G = gridDim.x, wg = blockIdx.x;
#ifdef MK_TSEL
    volatile LAS unsigned* tsb = (volatile LAS unsigned*)(lds + LDS_BYTES - 1280);
    if (MK_TID() == 0) tsb[0] = 0u;
#define MK_TS(tag) do { if (blockIdx.x == 0 && tid == 0) { const unsigned long long _t = __builtin_amdgcn_s_memrealtime(); const unsigned _n = tsb[0]; if (_n < 60) { tsb[1 + 3 * _n] = (tag); tsb[2 + 3 * _n] = (unsigned)_t; tsb[3 + 3 * _n] = (unsigned)(_t >> 32); tsb[0] = _n + 1; } } } while (0)
#else
#define MK_TS(tag) do { } while (0)
#endif
    for (int ph = a.ph_lo; ph < a.ph_hi; ++ph) {
        Ptrs p = a.p;
        const int ngw = G * NWAVES;
#define tid MK_TID()
#define wave (MK_TID() >> 6)
#define lane (MK_TID() & 63)
#define gw (wg * NWAVES + (MK_TID() >> 6))
        const int l = ph >= 6 ? 1 : 0; int sub = ph == 0 ? 0 : (ph == PH_FINAL ? 7 : ph - 5 * l); if (sub == 5) sub = 6;
        if (sub == 0) {
            MK_TS(0);
            p0_mod(p, (LAS float*)lds, wg, G, tid);
            p0_rope(p, wg * NT + tid, G * NT);
        } else if (sub == 1) {
            MK_TS(1);
            p1_norm(p, l, p.x, p.ctx, l == 1, gw, ngw, lane);
            if (l == 0) p0_weights(p, (LAS float*)lds + wave * (64 * 33), gw, ngw, lane);
        } else if (sub == 2) {
            MK_TS(2);
            pg8::Gemm g{(const pg8::bf16_t*)(p.ws + WS_H), (const pg8::bf16_t*)(p.ws + WS_WIN) + (size_t)l * NIN_PAD * 1024, M, NIN_PAD, 1024};
            EpiSeg E{p.ws, (float*)(p.ws + CTL_SSQ) + (size_t)l * 2 * M};
            if (l == 0) {
                pg8::StaticOrder S; S.init(M, NIN_PAD, G, wg);
                pg8::gemm_phase<EpiSeg, pg8::StaticOrder, false, MK_PG8_ALIGN, MK_PG8_SP2>(lds, g, S, E, nullptr, tid);
            } else {
                InOrderL1 S; S.lat.init(NLAT, NIN_PAD, G, wg); S.G = G; S.c = wg;
                pg8::gemm_phase<EpiSeg, InOrderL1, false, MK_PG8_ALIGN, MK_PG8_SP2>(lds, g, S, E, nullptr, tid);
            }
        } else if (sub == 3) {
            MK_TS(3);
            {
                const int Mq = l == 0 ? M : NLAT;
                pg8::Gemm g{(const pg8::bf16_t*)(p.ws + WS_CQ), (const pg8::bf16_t*)(p.ws + WS_WUQ) + (size_t)l * 768 * 384, Mq, 768, 384};
                pg8::StaticOrder S; S.init(Mq, 768, G, wg);
                EpiQup E{(bf16*)(p.ws + WS_QMLA)};
                pg8::gemm_phase<EpiQup, pg8::StaticOrder, false, MK_PG8_ALIGN, MK_PG8_SP2>(lds, g, S, E, nullptr, tid);
            }
            MK_TS(4);
            {
                pg8::Gemm g{(const pg8::bf16_t*)(p.ws + WS_CKV), (const pg8::bf16_t*)(p.ws + WS_WUKV) + (size_t)l * 768 * 256, M, 768, 256};
                pg8::StaticOrder S; S.init(M, 768, G, wg);
                EpiKVup E{(bf16*)(p.ws + WS_KVMLA), (const float*)(p.ws + CTL_SSQ) + (size_t)l * 2 * M + M};
                pg8::gemm_phase<EpiKVup, pg8::StaticOrder, false, MK_PG8_ALIGN, MK_PG8_SP2>(lds, g, S, E, nullptr, tid);
            }
            MK_TS(5);
            p3_qknorm(p, l, gw, ngw, lane);
            MK_TS(6);
            __syncthreads();
            p3_gdnprep(p, l, lds, wg, G, tid, NB);
            MK_TS(7);
        } else if (sub == 4) {
            MK_TS(8);
            p4_gdnscan(p, lds, WS_CQ, WS_CKV, wg, G, tid, NB);
            {
                unsigned* done = ctl + 4224 + 64 * l;
                int nch = 0; for (int ch = wg; ch < NB * 8; ch += G) ++nch;
                if (nch) {
                    asm volatile("s_waitcnt vmcnt(0)" ::: "memory");
                    __syncthreads();
                    if (tid == 0) { __builtin_amdgcn_fence(__ATOMIC_RELEASE, "agent"); asm volatile("s_waitcnt vmcnt(0)" ::: "memory"); __hip_atomic_fetch_add(done, (unsigned)nch, __ATOMIC_RELAXED, __HIP_MEMORY_SCOPE_AGENT); }
                }
            }
            MK_TS(9);
            {
                unsigned* ctr = ctl + 4096 + 64 * l;
                const int nunits = 1536 + (l == 0 ? 192 : 0);
                __syncthreads();
                if (tid == 0) misc[16] = __hip_atomic_fetch_add(ctr, 1u, __ATOMIC_RELAXED, __HIP_MEMORY_SCOPE_AGENT);
                __syncthreads();
                int u = (int)misc[16];
                while (u < nunits) {
                    unsigned nxt = 0u;
                    if (tid == 0) nxt = __hip_atomic_fetch_add(ctr, 1u, __ATOMIC_RELAXED, __HIP_MEMORY_SCOPE_AGENT);
                    attn_run_unit(p, l, lds, u, tid);
                    __syncthreads();
                    if (tid == 0) misc[16] = nxt;
                    __syncthreads();
                    u = (int)misc[16];
                }
            }
            MK_TS(10);
            {
                unsigned* done = ctl + 4224 + 64 * l;
                if (tid == 0) { unsigned sp = 0; while (__hip_atomic_load(done, __ATOMIC_RELAXED, __HIP_MEMORY_SCOPE_AGENT) < (unsigned)(NB * 8)) { __builtin_amdgcn_s_sleep(2); if (++sp > (1u << 22)) break; }
                    __builtin_amdgcn_fence(__ATOMIC_ACQUIRE, "agent"); asm volatile("s_waitcnt vmcnt(0)" ::: "memory"); }
                __syncthreads();
                p5_gdn_combine(p, l, l == 0 ? M : NLAT, gw, ngw, lane);
            }
        } else if (sub == 6) {
            MK_TS(12);
            const int Mo = l == 0 ? M : NLAT;
            pg8::Gemm g{(const pg8::bf16_t*)(p.ws + WS_GATE), (const pg8::bf16_t*)(p.ws + WS_WOUT) + (size_t)l * 1024 * 1024, Mo, 1024, 1024};
            pg8::StaticOrder S; S.init(Mo, 1024, G, wg);
            EpiY E{(bf16*)(p.ws + WS_H), (const float*)(p.ws + WS_MOD) + (size_t)l * 17 * 3072};
            pg8::gemm_phase<EpiY, pg8::StaticOrder, false, MK_PG8_ALIGN, MK_PG8_SP2>(lds, g, S, E, nullptr, tid);
        } else {
            MK_TS(13);
            p7_final(p, gw, ngw, lane);
#ifdef MK_TSEL
            MK_TS(15);
            if (blockIdx.x == 0 && tid == 0) {
                const unsigned n = tsb[0]; unsigned long long sel = 0;
                for (unsigned k = 0; k + 1 < n; ++k) { const unsigned tag = tsb[1 + 3 * k]; const unsigned long long t0 = ((unsigned long long)tsb[3 + 3 * k] << 32) | tsb[2 + 3 * k], t1 = ((unsigned long long)tsb[6 + 3 * k] << 32) | tsb[5 + 3 * k];
                    if ((MK_TSEL >> tag) & 1u) sel += t1 - t0; }
                const unsigned long long tend = __builtin_amdgcn_s_memrealtime();
                while (__builtin_amdgcn_s_memrealtime() - tend < (unsigned long long)MK_TMUL * sel) __builtin_amdgcn_s_sleep(8);
            }
#endif
        }
        if (ph + 1 < a.ph_hi) {
            MK_TS(14);
#if MK_COOP
            if (ph == 0) cooperative_groups::this_grid().sync(); else
#endif
            xcd_barrier(bar, tid);
        }
#undef tid
#undef wave
#undef lane
#undef gw
    }
}
}

#ifndef MK_N_LAUNCHES
#define MK_N_LAUNCHES 1
#endif
extern "C" void kernel_launch(void* const* d_in, const int* in_sizes, int n_in, void* d_out, int out_size, void* d_ws, size_t ws_size, hipStream_t stream) {
    static int grid = 0;
    if (grid == 0) {
        if (n_in != 20 || ws_size < mk::WS_END) { fprintf(stderr, "kernel_launch: unexpected n_in %d / ws_size %zu\n", n_in, ws_size); grid = -1; return; }
        int dev = 0, cus = 0, per_cu = 0;
        if (hipGetDevice(&dev) != hipSuccess || hipDeviceGetAttribute(&cus, hipDeviceAttributeMultiprocessorCount, dev) != hipSuccess) { grid = -1; return; }
        if (hipFuncSetAttribute((const void*)mk::mega, hipFuncAttributeMaxDynamicSharedMemorySize, mk::LDS_BYTES) != hipSuccess) { fprintf(stderr, "kernel_launch: hipFuncSetAttribute failed\n"); grid = -1; return; }
        if (hipOccupancyMaxActiveBlocksPerMultiprocessor(&per_cu, (const void*)mk::mega, mk::NT, mk::LDS_BYTES) != hipSuccess || per_cu < 1) { fprintf(stderr, "kernel_launch: occupancy query says %d blocks per CU\n", per_cu); grid = -1; return; }
        grid = cus;
    }
    if (grid < 0) return;
    (void)hipMemsetAsync((char*)d_ws + mk::WS_CTL, 0, mk::CTL_BYTES, stream);
    mk::KArgs a{};
    const float** pp = (const float**)&a.p;
    for (int i = 0; i < 20; ++i) pp[i] = (const float*)d_in[i];
    a.p.out = (float*)d_out; a.p.ws = (unsigned char*)d_ws;
    if (MK_N_LAUNCHES == 1) {
        a.ph_lo = 0; a.ph_hi = mk::N_PHASES;
        void* args[] = {&a};
#if MK_COOP
        const hipError_t e = hipLaunchCooperativeKernel((const void*)mk::mega, dim3(grid), dim3(mk::NT), args, mk::LDS_BYTES, stream);
#else
        const hipError_t e = hipLaunchKernel((const void*)mk::mega, dim3(grid), dim3(mk::NT), args, mk::LDS_BYTES, stream);
#endif
        if (e != hipSuccess) fprintf(stderr, "kernel_launch: launch failed: %s\n", hipGetErrorString(e));
    } else {
        for (int ph = 0; ph < mk::N_PHASES; ++ph) { a.ph_lo = ph; a.ph_hi = ph + 1; hipLaunchKernelGGL(mk::mega, dim3(grid), dim3(mk::NT), mk::LDS_BYTES, stream, a); }
    }
}
```

```cpp
#include <hip/hip_runtime.h>
#include <hip/hip_cooperative_groups.h>
#include <cstdio>
#include <cstdint>
#include <math.h>
namespace pg8 {
#define PG8_LAS __attribute__((address_space(3)))
typedef unsigned short bf16_t;
typedef short bf16x8 __attribute__((ext_vector_type(8)));
typedef float f32x4 __attribute__((ext_vector_type(4)));
typedef unsigned u32x4 __attribute__((ext_vector_type(4)));
constexpr int BM = 256, BK = 64, HALF = 128, HTB = HALF * BK * 2  , STAGE_BYTES = 8 * HTB, NXCD = 8, WGM = 8;

__host__ __device__ __forceinline__ int lds_byte(int r, int c) { const int st = (r >> 4) * 2 + (c >> 5), rr = r & 15, cc = c & 31, ob = rr * 64 + cc * 2; return st * 1024 + (ob ^ (((ob >> 9) & 1) << 5)); }
__host__ __device__ __forceinline__ void stage_rc(int b, int& R, int& C) { const int st = b / 1024, sb = b % 1024, swz = sb ^ (((sb >> 9) & 1) << 5); R = (st >> 1) * 16 + swz / 64; C = (st & 1) * 32 + (swz % 64) / 2; }
__host__ __device__ __forceinline__ int perm32(int rho) { const int n = rho >> 4, i = rho & 15; return 8 * (i >> 2) + 4 * n + (i & 3); }

struct Unit { int pm, pn; };
struct Gemm { const bf16_t* A; const bf16_t* Bt; int M, N, K; };

struct StaticOrder {
    int nM, nN, nwg, G, c;
    __host__ __device__ void init(int M, int N, int G_, int c_) { nM = M / BM; nN = N / BM; nwg = nM * nN; G = G_; c = c_; }
    __host__ __device__ bool next(int i, Unit& u) const {
        const long L = (long)i * G + c; if (L >= nwg) return false;
        int wgid = (int)L; { const int q = nwg / NXCD, r = nwg % NXCD, xcd = wgid % NXCD, off = wgid / NXCD; wgid = (xcd < r ? xcd * (q + 1) : r * (q + 1) + (xcd - r) * q) + off; }
        const int nig = WGM * nN, gid = wgid / nig, fm = gid * WGM, gsz = (nM - fm) < WGM ? (nM - fm) : WGM;
        u.pm = fm + ((wgid % nig) % gsz); u.pn = (wgid % nig) / gsz; return true;
    }
    __device__ __forceinline__ void a_ready(const Unit&) const {}
    __device__ __forceinline__ void done(const Unit&) const {}
};
__device__ __forceinline__ unsigned cvt_pk_bf16(float lo, float hi) { unsigned r; asm volatile("v_cvt_pk_bf16_f32 %0, %1, %2" : "=v"(r) : "v"(lo), "v"(hi)); return r; }
template <class Epi, class Sched, bool STAMP = false, bool ALIGN_EPI = false, bool SP2 = false>
__device__ __forceinline__ void gemm_phase(PG8_LAS unsigned char* lds, const Gemm g, const Sched& S, const Epi& E, unsigned long long* stamps, int tid_in) {
    int tid_ = tid_in; asm volatile("" : "+v"(tid_));
    const int tid = tid_, wid = __builtin_amdgcn_readfirstlane(tid >> 6), lane = tid & 63, wr = wid >> 2, wc = wid & 3, fr = lane & 15, fq = lane >> 4;
    const int K = g.K, nt = K / BK;
    int ts_lo = 0, ts_hi = 0, nts = 0; const unsigned long long rt_entry = STAMP ? (unsigned long long)wall_clock64() : 0ull;
#define PG8_STAMP() do { if (STAMP && wid == 0 && nts < 64) { const unsigned long long _c = (unsigned long long)clock64(); \
        ts_lo = (lane == nts) ? (int)(unsigned)_c : ts_lo; ts_hi = (lane == nts) ? (int)(unsigned)(_c >> 32) : ts_hi; ++nts; } } while (0)
    PG8_STAMP();
    unsigned voffA[2], voffB[2];
#pragma unroll
    for (int i = 0; i < 2; ++i) { int R, C; stage_rc(tid * 16 + i * 8192, R, C); const int Rb = Epi::PERM ? ((R & ~31) + perm32(R & 31)) : R;
        voffA[i] = (unsigned)(R * K + C) * 2u; voffB[i] = (unsigned)(Rb * K + C) * 2u; }
    const size_t kstep = (size_t)(BK * 2);
    const size_t hstep = (size_t)HALF * K * 2;
    const size_t tstep = 2 * hstep;
    const unsigned ldsw = (unsigned)wid * 1024u;
    const int aoff = lds_byte(wr * 64 + fr, fq * 8), boff = lds_byte(wc * 32 + fr, fq * 8);
#define PG8_SA(b, h) (((b) * 2 + (h)) * HTB)
#define PG8_SB(b, h) ((4 + (b) * 2 + (h)) * HTB)
#define PG8_STAGE(bufoff, gbase, voff) do { _Pragma("unroll") for (int _i = 0; _i < 2; ++_i) \
        __builtin_amdgcn_global_load_lds((const unsigned*)((const char*)(gbase) + (voff)[_i]), (PG8_LAS unsigned*)(lds + (bufoff) + ldsw + _i * 8192), 16, 0, 0); } while (0)
#define PG8_LDA(dst, b, h) do { _Pragma("unroll") for (int m = 0; m < 4; ++m) _Pragma("unroll") for (int k = 0; k < 2; ++k) dst[m][k] = *(const PG8_LAS bf16x8*)(lds + PG8_SA(b, h) + aoff + m * 2048 + k * 1024); } while (0)
#define PG8_LDB(dst, b, h) do { _Pragma("unroll") for (int n = 0; n < 2; ++n) _Pragma("unroll") for (int k = 0; k < 2; ++k) dst[n][k] = *(const PG8_LAS bf16x8*)(lds + PG8_SB(b, h) + boff + n * 2048 + k * 1024); } while (0)
#define PG8_MMA(ai, bj, At, Bt) do { __builtin_amdgcn_s_setprio(1); _Pragma("unroll") for (int m = 0; m < 4; ++m) _Pragma("unroll") for (int n = 0; n < 2; ++n) _Pragma("unroll") for (int k = 0; k < 2; ++k) \
        acc[ai][bj][m][n] = __builtin_amdgcn_mfma_f32_16x16x32_bf16(Bt[n][k], At[m][k], acc[ai][bj][m][n], 0, 0, 0); __builtin_amdgcn_s_setprio(0); } while (0)
#define PG8_WAIT_V(n) asm volatile("s_waitcnt vmcnt(" #n ")" ::: "memory")
#define PG8_WAIT_L(n) asm volatile("s_waitcnt lgkmcnt(" #n ")" ::: "memory")
#define PG8_BAR __builtin_amdgcn_s_barrier()
#define PG8_SCHED __builtin_amdgcn_sched_barrier(0)
    Unit cur, nxt; int ui = 0;
    if (!S.next(0, cur)) return;
    f32x4 acc[2][2][4][2];
#pragma unroll
    for (int a = 0; a < 2; ++a)
#pragma unroll
        for (int b = 0; b < 2; ++b)
#pragma unroll
            for (int m = 0; m < 4; ++m)
#pragma unroll
                for (int n = 0; n < 2; ++n) acc[a][b][m][n] = (f32x4){0.f, 0.f, 0.f, 0.f};
    bf16x8 At[4][2], B0[2][2], B1[2][2];
    const char* cA = (const char*)g.A + (size_t)cur.pm * tstep; const char* cB = (const char*)g.Bt + (size_t)cur.pn * tstep;
    S.a_ready(cur);
    if constexpr (SP2) {
        PG8_STAGE(PG8_SB(0, 0), cB, voffB); PG8_STAGE(PG8_SB(0, 1), cB + hstep, voffB); PG8_STAGE(PG8_SA(0, 0), cA, voffA); PG8_STAGE(PG8_SA(0, 1), cA + hstep, voffA);
        if (wr == 1) PG8_BAR;
        PG8_WAIT_V(2); PG8_BAR;
        PG8_STAGE(PG8_SB(1, 0), cB + kstep, voffB); PG8_STAGE(PG8_SA(1, 0), cA + kstep, voffA); PG8_STAGE(PG8_SB(1, 1), cB + hstep + kstep, voffB);
        PG8_WAIT_V(6); PG8_BAR;
    } else {
    PG8_STAGE(PG8_SB(0, 0), cB, voffB); PG8_STAGE(PG8_SA(0, 0), cA, voffA); PG8_STAGE(PG8_SB(0, 1), cB + hstep, voffB); PG8_STAGE(PG8_SA(0, 1), cA + hstep, voffA);
    if (wr == 1) PG8_BAR;
    PG8_WAIT_V(4); PG8_BAR;
    PG8_STAGE(PG8_SB(1, 0), cB + kstep, voffB); PG8_STAGE(PG8_SA(1, 0), cA + kstep, voffA); PG8_STAGE(PG8_SB(1, 1), cB + hstep + kstep, voffB);
    PG8_WAIT_V(6); PG8_BAR;
    }
    PG8_STAMP();
    for (;;) {
        const bool has_next = S.next(ui + 1, nxt);
        const char* nA = has_next ? (const char*)g.A + (size_t)nxt.pm * tstep : cA; const char* nB = has_next ? (const char*)g.Bt + (size_t)nxt.pn * tstep : cB;
#pragma unroll 1
        for (int t = 0; t < nt; t += 2) {
            const bool last = (t == nt - 2);
            const char* a1 = cA + (size_t)(t + 1) * kstep;
            const char* a2 = last ? nA : cA + (size_t)(t + 2) * kstep; const char* b2 = last ? nB : cB + (size_t)(t + 2) * kstep;
            const char* a3 = a2 + kstep; const char* b3 = b2 + kstep;
            if (last && has_next) S.a_ready(nxt);
            if constexpr (SP2) {
            PG8_LDB(B0, 0, 0); PG8_LDB(B1, 0, 1); PG8_SCHED; PG8_LDA(At, 0, 0); PG8_STAGE(PG8_SA(1, 1), a1 + hstep, voffA);
            PG8_WAIT_V(8); PG8_WAIT_L(0); PG8_BAR; PG8_MMA(0, 0, At, B0); PG8_MMA(0, 1, At, B1); PG8_BAR; PG8_SCHED;
            PG8_LDA(At, 0, 1); PG8_STAGE(PG8_SB(0, 0), b2, voffB); PG8_STAGE(PG8_SB(0, 1), b2 + hstep, voffB); PG8_STAGE(PG8_SA(0, 0), a2, voffA);
            PG8_WAIT_V(8); PG8_WAIT_L(0); PG8_BAR; PG8_MMA(1, 0, At, B0); PG8_MMA(1, 1, At, B1); PG8_BAR; PG8_SCHED;
            PG8_LDB(B0, 1, 0); PG8_LDB(B1, 1, 1); PG8_SCHED; PG8_LDA(At, 1, 0); PG8_STAGE(PG8_SA(0, 1), a2 + hstep, voffA);
            PG8_WAIT_V(8); PG8_WAIT_L(0); PG8_BAR; PG8_MMA(0, 0, At, B0); PG8_MMA(0, 1, At, B1); PG8_BAR; PG8_SCHED;
            PG8_LDA(At, 1, 1); PG8_STAGE(PG8_SB(1, 0), b3, voffB); PG8_STAGE(PG8_SB(1, 1), b3 + hstep, voffB); PG8_STAGE(PG8_SA(1, 0), a3, voffA);
            PG8_WAIT_V(8); PG8_WAIT_L(0); PG8_BAR; PG8_MMA(1, 0, At, B0); PG8_MMA(1, 1, At, B1); PG8_BAR; PG8_SCHED;
            } else {
            PG8_LDB(B0, 0, 0); PG8_SCHED; PG8_LDA(At, 0, 0); PG8_STAGE(PG8_SA(1, 1), a1 + hstep, voffA);
            PG8_WAIT_L(8); PG8_BAR; PG8_WAIT_L(0); PG8_MMA(0, 0, At, B0); PG8_BAR; PG8_SCHED;
            PG8_LDB(B1, 0, 1); PG8_STAGE(PG8_SB(0, 0), b2, voffB);
            PG8_BAR; PG8_WAIT_L(0); PG8_MMA(0, 1, At, B1); PG8_BAR;
            PG8_LDA(At, 0, 1); PG8_STAGE(PG8_SA(0, 0), a2, voffA);
            PG8_BAR; PG8_WAIT_L(0); PG8_MMA(1, 0, At, B0); PG8_BAR; PG8_SCHED;
            PG8_STAGE(PG8_SB(0, 1), b2 + hstep, voffB);
            PG8_WAIT_V(6); PG8_BAR; PG8_MMA(1, 1, At, B1); PG8_BAR;
            PG8_LDB(B0, 1, 0); PG8_SCHED; PG8_LDA(At, 1, 0); PG8_STAGE(PG8_SA(0, 1), a2 + hstep, voffA);
            PG8_WAIT_L(8); PG8_BAR; PG8_WAIT_L(0); PG8_MMA(0, 0, At, B0); PG8_BAR; PG8_SCHED;
            PG8_LDB(B1, 1, 1); PG8_STAGE(PG8_SB(1, 0), b3, voffB);
            PG8_BAR; PG8_WAIT_L(0); PG8_MMA(0, 1, At, B1); PG8_BAR;
            PG8_LDA(At, 1, 1); PG8_STAGE(PG8_SA(1, 0), a3, voffA);
            PG8_BAR; PG8_WAIT_L(0); PG8_MMA(1, 0, At, B0); PG8_BAR; PG8_SCHED;
            PG8_STAGE(PG8_SB(1, 1), b3 + hstep, voffB);
            PG8_WAIT_V(6); PG8_BAR; PG8_MMA(1, 1, At, B1); PG8_BAR;
            }
        }
        PG8_STAMP();
        if constexpr (ALIGN_EPI) { if (wr == 0) PG8_BAR; }
        if constexpr (!Epi::AFTER_DRAIN) { E(acc, cur, wr, wc, fr, fq); S.done(cur); }
        PG8_STAMP();
        if (!has_next) break;
#pragma unroll
        for (int a = 0; a < 2; ++a)
#pragma unroll
            for (int b = 0; b < 2; ++b)
#pragma unroll
                for (int m = 0; m < 4; ++m)
#pragma unroll
                    for (int n = 0; n < 2; ++n) acc[a][b][m][n] = (f32x4){0.f, 0.f, 0.f, 0.f};
        cur = nxt; cA = nA; cB = nB; ++ui;
        if constexpr (ALIGN_EPI) { if (wr == 1) PG8_BAR; }
    }
    PG8_WAIT_V(0);
    if constexpr (!ALIGN_EPI) { if (wr == 0) PG8_BAR; }
    PG8_BAR;
    if constexpr (Epi::AFTER_DRAIN) { E.fused(acc, cur, wr, wc, fr, fq, lds, wid, lane); S.done(cur); }
    PG8_STAMP();
    if (STAMP && wid == 0) { stamps[lane] = lane < nts ? (((unsigned long long)(unsigned)ts_hi << 32) | (unsigned)ts_lo) : 0ull;
        if (lane == 62) stamps[62] = rt_entry; if (lane == 63) stamps[63] = (unsigned long long)wall_clock64(); }
#undef PG8_STAMP
#undef PG8_SA
#undef PG8_SB
#undef PG8_STAGE
#undef PG8_LDA
#undef PG8_LDB
#undef PG8_MMA
#undef PG8_WAIT_V
#undef PG8_WAIT_L
#undef PG8_BAR
#undef PG8_SCHED
}
}
#define LAS __attribute__((address_space(3)))
#define DI __device__ __forceinline__
namespace mk {
typedef unsigned short bf16;
typedef unsigned u32x4 __attribute__((ext_vector_type(4)));
typedef unsigned u32x2 __attribute__((ext_vector_type(2)));
typedef float f32x4 __attribute__((ext_vector_type(4)));
constexpr int D = 1024, NB = 16, L = 2048, LC = 256, NLAT = NB * L, NCTX = NB * LC, M = NLAT + NCTX;
constexpr int NIN_PAD = 3328, NT = 512, NWAVES = 8;
constexpr int LDS_BYTES = 147456;
constexpr float EPS = 1e-6f;
constexpr int O_CQ = 0, O_CKV = 384, O_KR = 640, O_GQ = 672, O_GK = 1056, O_GV = 1184, O_GDN = 1312, O_B = 2080, O_A = 2088, O_GATE = 2096;

constexpr size_t MiB = 1u << 20;
constexpr size_t WS_CTL = 0, CTL_BYTES = 2 * MiB;
constexpr size_t CTL_SSQ = 1 * MiB;
constexpr size_t WS_MOD = 2 * MiB;
constexpr size_t WS_ROPE = WS_MOD + 512 * 1024;
constexpr size_t WS_WIN = 4 * MiB;
constexpr size_t WS_WUQ = 17 * MiB;
constexpr size_t WS_WUKV = 19 * MiB;
constexpr size_t WS_WOUT = 20 * MiB;
constexpr size_t WS_X1CTX = 24 * MiB;
constexpr size_t WS_CQ = 40 * MiB;
constexpr size_t WS_CKV = 67 * MiB;
constexpr size_t WS_KR = 85 * MiB;
constexpr size_t WS_BA = 88 * MiB;
constexpr size_t WS_GQ = 91 * MiB;
constexpr size_t WS_GK = 118 * MiB;
constexpr size_t WS_GV = 127 * MiB;
constexpr size_t WS_GDN = 136 * MiB;
constexpr size_t WS_GATE = 190 * MiB;
constexpr size_t WS_QMLA = 262 * MiB;
constexpr size_t WS_KVMLA = 303 * MiB;
constexpr size_t WS_GDNI = 357 * MiB;
constexpr size_t WS_H = WS_GDNI;
constexpr size_t WS_END = 512 * MiB;

DI unsigned f2bf(float f) { unsigned u = __builtin_bit_cast(unsigned, f); return (u + 0x7fffu + ((u >> 16) & 1u)) >> 16; }
typedef __bf16 bf2_t __attribute__((ext_vector_type(2)));
typedef float f32x2 __attribute__((ext_vector_type(2)));
DI unsigned pk2(float lo, float hi) { const f32x2 v = {lo, hi}; return __builtin_bit_cast(unsigned, __builtin_convertvector(v, bf2_t)); }
DI float bf2f(unsigned short b) { return __builtin_bit_cast(float, ((unsigned)b) << 16); }
DI float shx(float v, int mask, int lane) { return __builtin_bit_cast(float, __builtin_amdgcn_ds_bpermute((lane ^ mask) << 2, __builtin_bit_cast(int, v))); }
DI float shl_(float v, int src, int lane) { (void)lane; return __builtin_bit_cast(float, __builtin_amdgcn_ds_bpermute(src << 2, __builtin_bit_cast(int, v))); }
DI float wave_sum(float v, int lane) {
#pragma unroll
    for (int o = 32; o > 0; o >>= 1) v += shx(v, o, lane);
    return v;
}
DI float siluf(float x) { return x / (1.f + __expf(-x)); }

__host__ __device__ constexpr int rope_orig(int p) { return p < 16 ? ((p & 1) ? (p >> 1) + 8 : (p >> 1)) : 16 + (((p - 16) & 1) ? ((p - 16) >> 1) + 8 : ((p - 16) >> 1)); }

struct CmIn { DI int operator()(int n) const {
    const int hs = n >> 7, o = n & 127;
    if (hs < 3) return O_CQ + hs * 128 + o;
    if (hs == 3) return O_GK + o;
    if (hs < 6) return O_CKV + (hs - 4) * 128 + o;
    if (hs < 9) return O_GQ + (hs - 6) * 128 + o;
    if (hs == 9) return O_GV + o;
    if (hs < 16) return O_GDN + (hs - 10) * 128 + o;
    if (hs < 24) return O_GATE + (hs - 16) * 128 + o;
    if (hs == 24) { if (o < 32) return O_KR + rope_orig(o); if (o < 40) return O_B + (o - 32); if (o < 48) return O_A + (o - 40); }
    return -1; } };
struct CmUq { DI int operator()(int n) const { if (n >= 576) return -1; const int h = n / 96, d = n % 96; return d < 64 ? h * 96 + d : h * 96 + 64 + rope_orig(d - 64); } };
struct CmId { DI int operator()(int n) const { return n; } };

template <class CM> DI void wconv_item(const float* W, int K, int N, int NP, const float* kscale, bf16* Wt, int item, LAS float* scr, int lane, CM cm) {
    const int nblk = NP / 32, kb = item / nblk, nb = item % nblk, k0 = 64 * kb, n0 = 32 * nb;
    const int src = cm(n0 + (lane & 31));
#pragma unroll 8
    for (int i = 0; i < 32; ++i) { const int kk = 2 * i + (lane >> 5);
        float v = 0.f; if (src >= 0) { v = W[(size_t)(k0 + kk) * N + src]; if (kscale) v *= kscale[k0 + kk]; }
        scr[kk * 33 + (lane & 31)] = v; }
    asm volatile("s_waitcnt lgkmcnt(0)" ::: "memory");
    const int c = lane & 7;
#pragma unroll
    for (int j = 0; j < 4; ++j) { const int n = (lane >> 3) + 8 * j; const LAS float* s = scr + (8 * c) * 33 + n;
        u32x4 o; o.x = pk2(s[0 * 33], s[1 * 33]); o.y = pk2(s[2 * 33], s[3 * 33]); o.z = pk2(s[4 * 33], s[5 * 33]); o.w = pk2(s[6 * 33], s[7 * 33]);
        *(u32x4*)(Wt + (size_t)(n0 + n) * K + k0 + 8 * c) = o; }
    asm volatile("s_waitcnt lgkmcnt(0)" ::: "memory");
}

struct Ptrs {
    const float *x, *c, *ctx, *c_ctx, *w_ada, *b_ada, *norm_g, *w_in, *mla_qn_g, *mla_w_uq, *mla_kvn_g, *mla_w_ukv, *gqa_qn_g, *gqa_kn_g,
                *gdn_conv_w, *gdn_a_log, *gdn_dt_bias, *gdn_on_g, *w_out, *final_g;
    float* out; unsigned char* ws;
};

DI void p0_weights(const Ptrs& p, LAS float* scr, int gw, int ngw, int lane) {
    constexpr int I_IN = (1024 / 64) * (NIN_PAD / 32), I_UQ = (384 / 64) * (768 / 32), I_UKV = (256 / 64) * (768 / 32), I_OUT = (1024 / 64) * (1024 / 32);
    constexpr int PER_L = I_IN + I_UQ + I_UKV + I_OUT;
    for (int it = gw; it < 2 * PER_L; it += ngw) {
        const int l = it / PER_L; int r = it % PER_L;
        if (r < I_IN) { wconv_item(p.w_in + (size_t)l * 1024 * 3120, 1024, 3120, NIN_PAD, nullptr, (bf16*)(p.ws + WS_WIN) + (size_t)l * NIN_PAD * 1024, r, scr, lane, CmIn()); continue; } r -= I_IN;
        if (r < I_UQ) { wconv_item(p.mla_w_uq + (size_t)l * 384 * 576, 384, 576, 768, p.mla_qn_g + l * 384, (bf16*)(p.ws + WS_WUQ) + (size_t)l * 768 * 384, r, scr, lane, CmUq()); continue; } r -= I_UQ;
        if (r < I_UKV) { wconv_item(p.mla_w_ukv + (size_t)l * 256 * 768, 256, 768, 768, p.mla_kvn_g + l * 256, (bf16*)(p.ws + WS_WUKV) + (size_t)l * 768 * 256, r, scr, lane, CmId()); continue; } r -= I_UKV;
        wconv_item(p.w_out + (size_t)l * 1024 * 1024, 1024, 1024, 1024, nullptr, (bf16*)(p.ws + WS_WOUT) + (size_t)l * 1024 * 1024, r, scr, lane, CmId());
    }
}

DI void p0_mod(const Ptrs& p, int gtid, int ngt) {
    float* mod = (float*)(p.ws + WS_MOD);
    for (int o = gtid; o < 2 * 3072; o += ngt) {
        const int l = o / 3072, j = o % 3072;
        const float* w = p.w_ada + (size_t)l * 1024 * 3072 + j;
        float acc[17];
#pragma unroll
        for (int r = 0; r < 17; ++r) acc[r] = 0.f;
        for (int k = 0; k < 1024; ++k) {
            const float wv = w[(size_t)k * 3072];
#pragma unroll
            for (int r = 0; r < 16; ++r) { const float cv = p.c[r * 1024 + k]; acc[r] += (cv / (1.f + expf(-cv))) * wv; }
            { const float cv = p.c_ctx[k]; acc[16] += (cv / (1.f + expf(-cv))) * wv; }
        }
        const float bb = p.b_ada[l * 3072 + j];
#pragma unroll
        for (int r = 0; r < 17; ++r) mod[((size_t)l * 17 + r) * 3072 + j] = acc[r] + bb;
    }
}

DI void p1_norm(const Ptrs& p, int l, const float* xlat, const float* xctx, bool addy, int gw, int ngw, int lane) {
    const float* mod = (const float*)(p.ws + WS_MOD) + (size_t)l * 17 * 3072;
    const float* g = p.norm_g + l * 1024;
    bf16* H = (bf16*)(p.ws + WS_H);
    const int rpw = (M + ngw - 1) / ngw, rbeg = gw * rpw, rend = rbeg + rpw < M ? rbeg + rpw : M;
    f32x4 gs[4], sh[4];
    int cur_mrow = -1;
    f32x4 v0[4], v1[4]; u32x2 y0[4], y1[4];
#define MK_P1_LOAD(R_, A0, A1, Y0, Y1) do { const int _R = (R_), _R1 = _R + 1 < rend ? _R + 1 : _R; \
        const float* _x0 = _R >= NLAT ? xctx + (size_t)(_R - NLAT) * 1024 : xlat + (size_t)_R * 1024; \
        const float* _x1 = _R1 >= NLAT ? xctx + (size_t)(_R1 - NLAT) * 1024 : xlat + (size_t)_R1 * 1024; \
        _Pragma("unroll") for (int j = 0; j < 4; ++j) { A0[j] = *(const f32x4*)(_x0 + lane * 4 + 256 * j); A1[j] = *(const f32x4*)(_x1 + lane * 4 + 256 * j); } \
        if (addy) { _Pragma("unroll") for (int j = 0; j < 4; ++j) { Y0[j] = *(const u32x2*)(H + (size_t)_R * 1024 + lane * 4 + 256 * j); Y1[j] = *(const u32x2*)(H + (size_t)_R1 * 1024 + lane * 4 + 256 * j); } } } while (0)
    f32x4 n0[4], n1[4]; u32x2 ny0[4], ny1[4];
    if (rbeg < rend) MK_P1_LOAD(rbeg, v0, v1, y0, y1);
    if (rbeg + 2 < rend) MK_P1_LOAD(rbeg + 2, n0, n1, ny0, ny1);
    for (int R = rbeg; R < rend; R += 2) {
        const bool two = R + 1 < rend;
        const int R1 = two ? R + 1 : R;
        const bool more = R + 2 < rend, more2 = R + 4 < rend;
        f32x4 m0[4], m1[4]; u32x2 my0[4], my1[4];
        if (more2) MK_P1_LOAD(R + 4, m0, m1, my0, my1);
        if (addy) {
#pragma unroll
            for (int j = 0; j < 4; ++j) {
                v0[j] = (f32x4){v0[j].x + __builtin_bit_cast(float, y0[j].x << 16), v0[j].y + __builtin_bit_cast(float, y0[j].x & 0xffff0000u), v0[j].z + __builtin_bit_cast(float, y0[j].y << 16), v0[j].w + __builtin_bit_cast(float, y0[j].y & 0xffff0000u)};
                v1[j] = (f32x4){v1[j].x + __builtin_bit_cast(float, y1[j].x << 16), v1[j].y + __builtin_bit_cast(float, y1[j].x & 0xffff0000u), v1[j].z + __builtin_bit_cast(float, y1[j].y << 16), v1[j].w + __builtin_bit_cast(float, y1[j].y & 0xffff0000u)}; }
            if (R < NLAT) {
#pragma unroll
                for (int j = 0; j < 4; ++j) *(f32x4*)(p.out + (size_t)R * 1024 + lane * 4 + 256 * j) = v0[j]; }
            if (two && R1 < NLAT) {
#pragma unroll
                for (int j = 0; j < 4; ++j) *(f32x4*)(p.out + (size_t)R1 * 1024 + lane * 4 + 256 * j) = v1[j]; }
        }
#pragma unroll
        for (int rr = 0; rr < 2; ++rr) {
            if (rr == 1 && !two) break;
            const int Rr = rr ? R1 : R;
            const int mrow = Rr >= NLAT ? 16 : (Rr >> 11);
            if (mrow != cur_mrow) { cur_mrow = mrow; const float* md = mod + (size_t)mrow * 3072;
#pragma unroll
                for (int j = 0; j < 4; ++j) { const int c = lane * 4 + 256 * j; const f32x4 gg = *(const f32x4*)(g + c), sc = *(const f32x4*)(md + 1024 + c);
                    gs[j] = (f32x4){gg.x * (1.f + sc.x), gg.y * (1.f + sc.y), gg.z * (1.f + sc.z), gg.w * (1.f + sc.w)}; sh[j] = *(const f32x4*)(md + c); } }
            float ss = 0.f;
#pragma unroll
            for (int j = 0; j < 4; ++j) { const f32x4 v = rr ? v1[j] : v0[j]; ss += (v.x * v.x + v.y * v.y) + (v.z * v.z + v.w * v.w); }
            ss = wave_sum(ss, lane);
            const float rstd = 1.f / sqrtf(ss * (1.f / 1024.f) + EPS);
#pragma unroll
            for (int j = 0; j < 4; ++j) { const int c = lane * 4 + 256 * j; const f32x4 v = rr ? v1[j] : v0[j];
                u32x2 o; o.x = pk2(v.x * rstd * gs[j].x + sh[j].x, v.y * rstd * gs[j].y + sh[j].y); o.y = pk2(v.z * rstd * gs[j].z + sh[j].z, v.w * rstd * gs[j].w + sh[j].w);
                *(u32x2*)(H + (size_t)Rr * 1024 + c) = o; }
        }
        if (more) {
#pragma unroll
            for (int j = 0; j < 4; ++j) { v0[j] = n0[j]; v1[j] = n1[j]; y0[j] = ny0[j]; y1[j] = ny1[j]; }
        }
        if (more2) {
#pragma unroll
            for (int j = 0; j < 4; ++j) { n0[j] = m0[j]; n1[j] = m1[j]; ny0[j] = my0[j]; ny1[j] = my1[j]; }
        }
    }
#undef MK_P1_LOAD
}

struct EpiSeg {
    static constexpr bool PERM = true, AFTER_DRAIN = false;
    unsigned char* ws; float* ss;
    DI void operator()(const pg8::f32x4 (&acc)[2][2][4][2], const pg8::Unit& u, int wr, int wc, int fr, int fq) const {
        const int row0 = u.pm * 256 + wr * 64 + fr, colh = 32 * wc + 8 * fq;
#pragma unroll
        for (int bj = 0; bj < 2; ++bj) {
            const int hs = 2 * u.pn + bj;
            bf16* dst; int ld, c0, kind = 0;
            if (hs < 3) { dst = (bf16*)(ws + WS_CQ); ld = 384; c0 = hs * 128; kind = 1; }
            else if (hs == 3) { dst = (bf16*)(ws + WS_GK); ld = 128; c0 = 0; }
            else if (hs < 6) { dst = (bf16*)(ws + WS_CKV); ld = 256; c0 = (hs - 4) * 128; kind = 2; }
            else if (hs < 9) { dst = (bf16*)(ws + WS_GQ); ld = 384; c0 = (hs - 6) * 128; }
            else if (hs == 9) { dst = (bf16*)(ws + WS_GV); ld = 128; c0 = 0; }
            else if (hs < 16) { dst = (bf16*)(ws + WS_GDN); ld = 768; c0 = (hs - 10) * 128; }
            else if (hs < 24) { dst = (bf16*)(ws + WS_GATE); ld = 1024; c0 = (hs - 16) * 128; }
            else if (hs == 24) { dst = (bf16*)(ws + WS_KR); ld = 32; c0 = 0; kind = 3; }
            else { dst = nullptr; ld = 0; c0 = 0; kind = 4; }
            if (kind == 4) continue;
            if (kind == 3) {
                if (wc == 0) {
#pragma unroll
                    for (int ai = 0; ai < 2; ++ai)
#pragma unroll
                        for (int m = 0; m < 4; ++m) { const int row = row0 + ai * 128 + m * 16; const pg8::f32x4 v0 = acc[ai][bj][m][0], v1 = acc[ai][bj][m][1];
                            u32x4 w; w.x = pk2(v0[0], v0[1]); w.y = pk2(v0[2], v0[3]); w.z = pk2(v1[0], v1[1]); w.w = pk2(v1[2], v1[3]);
                            *(u32x4*)(dst + (size_t)row * 32 + 8 * fq) = w; }
                } else if (wc == 1 && fq < 2) {
                    float* ba = (float*)(ws + WS_BA);
#pragma unroll
                    for (int ai = 0; ai < 2; ++ai)
#pragma unroll
                        for (int m = 0; m < 4; ++m) { const int row = row0 + ai * 128 + m * 16;
                            *(pg8::f32x4*)(ba + (size_t)row * 16 + 8 * fq) = acc[ai][bj][m][0]; *(pg8::f32x4*)(ba + (size_t)row * 16 + 8 * fq + 4) = acc[ai][bj][m][1]; }
                }
                continue;
            }
#pragma unroll
            for (int ai = 0; ai < 2; ++ai)
#pragma unroll
                for (int m = 0; m < 4; ++m) { const int row = row0 + ai * 128 + m * 16; const pg8::f32x4 v0 = acc[ai][bj][m][0], v1 = acc[ai][bj][m][1];
                    u32x4 w; w.x = pk2(v0[0], v0[1]); w.y = pk2(v0[2], v0[3]); w.z = pk2(v1[0], v1[1]); w.w = pk2(v1[2], v1[3]);
                    *(u32x4*)(dst + (size_t)row * ld + c0 + colh) = w;
                    if (kind == 1 || kind == 2) {
                        float s = (v0[0] * v0[0] + v0[1] * v0[1]) + (v0[2] * v0[2] + v0[3] * v0[3]) + (v1[0] * v1[0] + v1[1] * v1[1]) + (v1[2] * v1[2] + v1[3] * v1[3]);
                        s += shx(s, 16, fr + 16 * fq); s += shx(s, 32, fr + 16 * fq);
                        if (fq == 0) atomicAdd(ss + (kind == 2 ? M : 0) + row, s);
                    } }
        }
    }
};
}

#define XB_TMO      128
#define XB_XCNT(j)  (256  + 64 * (j))
#define XB_XSUB(j)  (1280 + 64 * (j))
#define XB_XGEN(j)  (2304 + 64 * (j))
#define XB_TOP      3328
#define XB_TOPGEN   3392
#define XCD_BAR_WORDS 3456
#define XB_SPIN_CAP (1u << 18)
__device__ __forceinline__ unsigned xb_ld(unsigned* p)              { return __hip_atomic_load(p, __ATOMIC_RELAXED, __HIP_MEMORY_SCOPE_AGENT); }
__device__ __forceinline__ unsigned xb_add(unsigned* p, unsigned v) { return __hip_atomic_fetch_add(p, v, __ATOMIC_RELAXED, __HIP_MEMORY_SCOPE_AGENT); }
__device__ __forceinline__ unsigned xb_xcc_id() { return (unsigned)__builtin_amdgcn_s_getreg((3 << 11) | 20) & 0xFu; }
#define XB_SPIN(cond, bar) do { unsigned _sp = 0; while (cond) { __builtin_amdgcn_s_sleep(1); \
    if ((++_sp & 255u) == 0u) { if (xb_ld(&(bar)[XB_TMO])) break; if (_sp > XB_SPIN_CAP) { atomicAdd(&(bar)[XB_TMO], 1u); break; } } } } while (0)
struct XcdBarrier { unsigned* bar; unsigned x; volatile LAS unsigned* st; };
__device__ __forceinline__ XcdBarrier xcd_barrier_post(unsigned* bar, volatile LAS unsigned* st, int tid) {
    XcdBarrier b; b.bar = bar; b.x = xb_xcc_id(); b.st = st;
    if (tid == 0) (void)xb_add(&bar[XB_XCNT(b.x)], 1u);
    return b;
}
__device__ __forceinline__ void xcd_barrier_complete(unsigned* bar, unsigned x, unsigned& nloc, unsigned& nx) {
    const unsigned G = gridDim.x * gridDim.y * gridDim.z;
    unsigned sum, cnt, mine, sp = 0u;
    for (;;) {
        sum = 0u; cnt = 0u; mine = 0u;
#pragma unroll
        for (unsigned j = 0; j < 16; ++j) { const unsigned c = xb_ld(&bar[XB_XCNT(j)]); sum += c; cnt += (c > 0u) ? 1u : 0u; mine = (j == x) ? c : mine; }
        if (sum == G) break;
        __builtin_amdgcn_s_sleep(1);
        if ((++sp & 255u) == 0u) { if (xb_ld(&bar[XB_TMO])) break; if (sp > XB_SPIN_CAP) { atomicAdd(&bar[XB_TMO], 1u); break; } }
    }
    nloc = mine > 0u ? mine : 1u; nx = cnt > 0u ? cnt : 1u;
}
__device__ __forceinline__ void xcd_barrier(const XcdBarrier& b, int tid) {
    asm volatile("s_waitcnt vmcnt(0)" ::: "memory");
    __syncthreads();
    if (tid == 0) {
        unsigned* bar = b.bar;
        __builtin_amdgcn_s_waitcnt(0);
        unsigned nloc = b.st[0], nx = b.st[1];
        if (nloc == 0u) { xcd_barrier_complete(bar, b.x, nloc, nx); b.st[0] = nloc; b.st[1] = nx; }
        const unsigned old = xb_add(&bar[XB_XSUB(b.x)], 1u);
        const unsigned gen = old / nloc;
        if (old + 1u == (gen + 1u) * nloc) {
            __builtin_amdgcn_fence(__ATOMIC_RELEASE, "agent");
            asm volatile("s_waitcnt vmcnt(0)" ::: "memory");
            const unsigned og = xb_add(&bar[XB_TOP], 1u);
            const unsigned tg = og / nx;
            if (og + 1u == (tg + 1u) * nx) xb_add(&bar[XB_TOPGEN], 1u);
            else XB_SPIN(xb_ld(&bar[XB_TOPGEN]) == tg, bar);
            __builtin_amdgcn_fence(__ATOMIC_ACQUIRE, "agent");
            xb_add(&bar[XB_XGEN(b.x)], 1u);
            asm volatile("s_waitcnt vmcnt(0)" ::: "memory");
        } else {
            XB_SPIN(xb_ld(&bar[XB_XGEN(b.x)]) == gen, bar);
            __builtin_amdgcn_fence(__ATOMIC_ACQUIRE, "agent");
            asm volatile("s_waitcnt vmcnt(0)" ::: "memory");
        }
    }
    __syncthreads();
}
namespace mk {
DI void p0_mod(const Ptrs& p, LAS float* lds, int wg, int nwg, int tid) {
    LAS float* s = lds; LAS float* red = lds + 17 * 1024;
    float* mod = (float*)(p.ws + WS_MOD);
    for (int i = tid; i < 17 * 1024; i += NT) { const float cv = i < 16384 ? p.c[i] : p.c_ctx[i - 16384]; s[i] = cv / (1.f + expf(-cv)); }
    __syncthreads();
    for (int blk = wg; blk < 192; blk += nwg) {
        const int l = blk / 96, j0 = (blk % 96) * 32, col = tid & 31, ks = tid >> 5;
        const float* w = p.w_ada + (size_t)l * 1024 * 3072 + j0 + col;
        float acc[17];
#pragma unroll
        for (int r = 0; r < 17; ++r) acc[r] = 0.f;
        for (int kk = 0; kk < 64; ++kk) { const int k = ks * 64 + kk; const float wv = w[(size_t)k * 3072];
#pragma unroll
            for (int r = 0; r < 17; ++r) acc[r] += s[r * 1024 + k] * wv; }
#pragma unroll
        for (int r = 0; r < 17; ++r) red[(r * 16 + ks) * 32 + col] = acc[r];
        __syncthreads();
        for (int o = tid; o < 17 * 32; o += NT) { const int r = o / 32, c = o % 32; float t = 0.f;
#pragma unroll
            for (int q = 0; q < 16; ++q) t += red[(r * 16 + q) * 32 + c];
            mod[((size_t)l * 17 + r) * 3072 + j0 + c] = t + p.b_ada[l * 3072 + j0 + c]; }
        __syncthreads();
    }
}
}
namespace mk {
constexpr size_t ROPE_M_OFF = 0, ROPE_G_OFF = 64 * 8 * 2 * 4;
DI void p0_rope(const Ptrs& p, int gtid, int ngt) {
    float* tm = (float*)(p.ws + WS_ROPE + ROPE_M_OFF); float* tg = (float*)(p.ws + WS_ROPE + ROPE_G_OFF);
    for (int o = gtid; o < 64 * 8 + 64 * 16; o += ngt) {
        if (o < 512) { const int pos = o >> 3, i = o & 7; const float inv = powf(10000.f, -(float)(2 * i) / 16.f), ang = (float)pos * inv; tm[2 * o] = cosf(ang); tm[2 * o + 1] = sinf(ang); }
        else { const int q = o - 512, pos = q >> 4, i = q & 15; const float inv = powf(10000.f, -(float)(2 * i) / 32.f), ang = (float)pos * inv; tg[2 * q] = cosf(ang); tg[2 * q + 1] = sinf(ang); }
    }
}

struct EpiQup {
    static constexpr bool PERM = true, AFTER_DRAIN = false;
    bf16* Q;
    DI void operator()(const pg8::f32x4 (&acc)[2][2][4][2], const pg8::Unit& u, int wr, int wc, int fr, int fq) const {
        const int row0 = u.pm * 256 + wr * 64 + fr;
#pragma unroll
        for (int bj = 0; bj < 2; ++bj) {
            const int c = 256 * u.pn + 128 * bj + 32 * wc + 8 * fq;
            if (c >= 576) continue;
#pragma unroll
            for (int ai = 0; ai < 2; ++ai)
#pragma unroll
                for (int m = 0; m < 4; ++m) { const int row = row0 + ai * 128 + m * 16;
                    const pg8::f32x4 v0 = acc[ai][bj][m][0], v1 = acc[ai][bj][m][1];
                    u32x4 w; w.x = pk2(v0[0], v0[1]); w.y = pk2(v0[2], v0[3]); w.z = pk2(v1[0], v1[1]); w.w = pk2(v1[2], v1[3]);
                    *(u32x4*)(Q + (size_t)row * 576 + c) = w; }
        }
    }
};
struct EpiKVup {
    static constexpr bool PERM = true, AFTER_DRAIN = false;
    bf16* KV; const float* sskv;
    DI void operator()(const pg8::f32x4 (&acc)[2][2][4][2], const pg8::Unit& u, int wr, int wc, int fr, int fq) const {
        const int row0 = u.pm * 256 + wr * 64 + fr;
#pragma unroll
        for (int bj = 0; bj < 2; ++bj) {
            const int c = 256 * u.pn + 128 * bj + 32 * wc + 8 * fq;
#pragma unroll
            for (int ai = 0; ai < 2; ++ai)
#pragma unroll
                for (int m = 0; m < 4; ++m) { const int row = row0 + ai * 128 + m * 16;
                    const float rstd = 1.f / sqrtf(sskv[row] * (1.f / 256.f) + EPS);
                    const pg8::f32x4 v0 = acc[ai][bj][m][0] * rstd, v1 = acc[ai][bj][m][1] * rstd;
                    u32x4 w; w.x = pk2(v0[0], v0[1]); w.y = pk2(v0[2], v0[3]); w.z = pk2(v1[0], v1[1]); w.w = pk2(v1[2], v1[3]);
                    *(u32x4*)(KV + (size_t)row * 768 + c) = w; }
        }
    }
};

DI void p3_qknorm(const Ptrs& p, int l, int gw, int ngw, int lane) {
    bf16* GQ = (bf16*)(p.ws + WS_GQ); bf16* GK = (bf16*)(p.ws + WS_GK); bf16* KR = (bf16*)(p.ws + WS_KR);
    const float* ropeM = (const float*)(p.ws + WS_ROPE + ROPE_M_OFF); const float* ropeG = (const float*)(p.ws + WS_ROPE + ROPE_G_OFF);
    const bool isq = lane < 48;
    const int l8 = lane & 7, dbase = 8 * l8;
    const float* gain = (isq ? p.gqa_qn_g : p.gqa_kn_g) + l * 64 + dbase;
    float gn[8];
#pragma unroll
    for (int j = 0; j < 8; ++j) gn[j] = gain[j];
    const int rpw = (M + ngw - 1) / ngw, rbeg = gw * rpw, rend = rbeg + rpw < M ? rbeg + rpw : M;
    u32x4 raw2[2], kraw2[2];
#define MK_QKN_LOAD(Rb_, RAW, KRAW) do { _Pragma("unroll") for (int rr = 0; rr < 2; ++rr) { const int R = (rr && (Rb_) + 1 < rend) ? (Rb_) + 1 : (Rb_); \
            RAW[rr] = *(const u32x4*)(isq ? GQ + (size_t)R * 384 + lane * 8 : GK + (size_t)R * 128 + (lane - 48) * 8); \
            KRAW[rr] = (R < NLAT && lane < 4) ? *(const u32x4*)(KR + (size_t)R * 32 + lane * 8) : (u32x4){0u, 0u, 0u, 0u}; } } while (0)
    if (rbeg < rend) MK_QKN_LOAD(rbeg, raw2, kraw2);
    for (int Rb = rbeg; Rb < rend; Rb += 2) {
        const bool two = Rb + 1 < rend;
        const bool more = Rb + 2 < rend;
        u32x4 nraw2[2], nkraw2[2];
        if (more) MK_QKN_LOAD(Rb + 2, nraw2, nkraw2);
#pragma unroll
        for (int rr = 0; rr < 2; ++rr) {
            if (rr == 1 && !two) break;
            const int R = Rb + rr;
            bf16* ptr = isq ? GQ + (size_t)R * 384 + lane * 8 : GK + (size_t)R * 128 + (lane - 48) * 8;
            const u32x4 raw = raw2[rr];
            float x[8];
            x[0] = __builtin_bit_cast(float, raw.x << 16); x[1] = __builtin_bit_cast(float, raw.x & 0xffff0000u);
            x[2] = __builtin_bit_cast(float, raw.y << 16); x[3] = __builtin_bit_cast(float, raw.y & 0xffff0000u);
            x[4] = __builtin_bit_cast(float, raw.z << 16); x[5] = __builtin_bit_cast(float, raw.z & 0xffff0000u);
            x[6] = __builtin_bit_cast(float, raw.w << 16); x[7] = __builtin_bit_cast(float, raw.w & 0xffff0000u);
            float ss = 0.f;
#pragma unroll
            for (int j = 0; j < 8; ++j) ss += x[j] * x[j];
            ss += shx(ss, 1, lane); ss += shx(ss, 2, lane); ss += shx(ss, 4, lane);
            const float rstd = 1.f / sqrtf(ss * (1.f / 64.f) + EPS);
            float y[8];
#pragma unroll
            for (int j = 0; j < 8; ++j) y[j] = x[j] * rstd * gn[j];
            if (R < NLAT) {
                const int t = R & 2047, pos = (l8 < 4) ? (t >> 6) : (t & 63), i0 = 8 * (l8 & 1);
                const float* tb = ropeG + (pos * 16 + i0) * 2;
                const bool upper = (l8 & 2) != 0;
#pragma unroll
                for (int j = 0; j < 8; ++j) { const float partner = shx(y[j], 2, lane); const float cs = tb[2 * j], sn = tb[2 * j + 1];
                    y[j] = upper ? y[j] * cs + partner * sn : y[j] * cs - partner * sn; }
            }
            u32x4 o; o.x = pk2(y[0], y[1]); o.y = pk2(y[2], y[3]); o.z = pk2(y[4], y[5]); o.w = pk2(y[6], y[7]);
            *(u32x4*)ptr = o;
            if (R < NLAT && lane < 4) {
                bf16* kp = KR + (size_t)R * 32 + lane * 8;
                const u32x4 kraw = kraw2[rr];
                const int t = R & 2047, p0 = 8 * lane, pos = p0 < 16 ? (t >> 6) : (t & 63), i0 = (p0 & 15) >> 1;
                const float* tb = ropeM + (pos * 8 + i0) * 2;
                const unsigned w[4] = {kraw.x, kraw.y, kraw.z, kraw.w}; unsigned ow[4];
#pragma unroll
                for (int j = 0; j < 4; ++j) { const float x1 = __builtin_bit_cast(float, w[j] << 16), x2 = __builtin_bit_cast(float, w[j] & 0xffff0000u), cs = tb[2 * j], sn = tb[2 * j + 1];
                    ow[j] = pk2(x1 * cs - x2 * sn, x2 * cs + x1 * sn); }
                *(u32x4*)kp = (u32x4){ow[0], ow[1], ow[2], ow[3]};
            }
        }
        if (more) { raw2[0] = nraw2[0]; raw2[1] = nraw2[1]; kraw2[0] = nkraw2[0]; kraw2[1] = nkraw2[1]; }
    }
#undef MK_QKN_LOAD
}
}
namespace mk {
typedef short bf16x8 __attribute__((ext_vector_type(8)));
typedef short s16x4 __attribute__((ext_vector_type(4)));
typedef float f32x16 __attribute__((ext_vector_type(16)));
#define MK_SBAR() __builtin_amdgcn_sched_barrier(0)
#define MK_MFMA32(a, b, c) __builtin_amdgcn_mfma_f32_32x32x16_bf16((a), (b), (c), 0, 0, 0)
template <int OFF> DI s16x4 tr_read(unsigned addr) { s16x4 r; asm volatile("ds_read_b64_tr_b16 %0, %1 offset:%2" : "=&v"(r) : "v"(addr), "i"(OFF) : "memory"); return r; }
DI float lo_bf(unsigned w) { return __builtin_bit_cast(float, w << 16); }
DI float hi_bf(unsigned w) { return __builtin_bit_cast(float, w & 0xffff0000u); }
DI bf16x8 pack8(const f32x16& x, int base) {
    u32x4 w; w.x = pk2(x[base + 0], x[base + 1]); w.y = pk2(x[base + 2], x[base + 3]); w.z = pk2(x[base + 4], x[base + 5]); w.w = pk2(x[base + 6], x[base + 7]);
    return __builtin_bit_cast(bf16x8, w);
}
template <int DVT> DI void pv_one(f32x16& od, unsigned vb, bf16x8 pb0, bf16x8 pb1, bf16x8 pb2, bf16x8 pb3) {
    const s16x4 l0 = tr_read<DVT * 4096 + 0>(vb), h0 = tr_read<DVT * 4096 + 512>(vb), l1 = tr_read<DVT * 4096 + 1024>(vb), h1 = tr_read<DVT * 4096 + 1536>(vb);
    const s16x4 l2 = tr_read<DVT * 4096 + 2048>(vb), h2 = tr_read<DVT * 4096 + 2560>(vb), l3 = tr_read<DVT * 4096 + 3072>(vb), h3 = tr_read<DVT * 4096 + 3584>(vb);
    asm volatile("s_waitcnt lgkmcnt(0)" ::: "memory"); MK_SBAR();
#define MK_PKV(L, H) (bf16x8){L[0], L[1], L[2], L[3], H[0], H[1], H[2], H[3]}
    od = MK_MFMA32(MK_PKV(l0, h0), pb0, od); od = MK_MFMA32(MK_PKV(l1, h1), pb1, od); od = MK_MFMA32(MK_PKV(l2, h2), pb2, od); od = MK_MFMA32(MK_PKV(l3, h3), pb3, od);
#undef MK_PKV
}

template <bool MLA>
DI void attn_unit(const Ptrs& p, int l, LAS unsigned char* lds, int b, int h, int qb, bool ctxq, int tid) {
    asm volatile("" : "+v"(tid));
    constexpr int DQ = MLA ? 96 : 64, NS = DQ / 16, KSTR = DQ * 2 + 16, KBUF = 64 * KSTR, VBUF = 8192, CPR = DQ / 8;
    constexpr float LOG2E = 1.4426950408889634f, THR2 = 8.f * LOG2E;
    const int wave = tid >> 6, lane = tid & 63, r32 = lane & 31, hh = lane >> 5;
    const int qrow = (ctxq ? NLAT + b * 256 : b * 2048 + qb * 256) + wave * 32 + r32;
    const int hk = MLA ? h : h / 3;
    const bf16* Ksrc = MLA ? (const bf16*)(p.ws + WS_KVMLA) + hk * 128 : (const bf16*)(p.ws + WS_GK) + hk * 64;
    const bf16* Vsrc = MLA ? (const bf16*)(p.ws + WS_KVMLA) + hk * 128 + 64 : (const bf16*)(p.ws + WS_GV) + hk * 64;
    const bf16* KRsrc = (const bf16*)(p.ws + WS_KR);
    constexpr int LDKV = MLA ? 768 : 128;
    bf16x8 qf[NS];
    float c_lane;
    {
        const bf16* qp = MLA ? (const bf16*)(p.ws + WS_QMLA) + (size_t)qrow * 576 + h * 96 + hh * 8 : (const bf16*)(p.ws + WS_GQ) + (size_t)qrow * 384 + h * 64 + hh * 8;
#pragma unroll
        for (int s = 0; s < NS; ++s) qf[s] = *(const bf16x8*)(qp + 16 * s);
        if constexpr (MLA) {
            const float ssq = ((const float*)(p.ws + CTL_SSQ))[(size_t)l * 2 * M + qrow];
            c_lane = 0.10206207261596577f * LOG2E / sqrtf(ssq * (1.f / 384.f) + EPS);
            if (!ctxq) {
                const float* ropeM = (const float*)(p.ws + WS_ROPE + ROPE_M_OFF);
                const int t = qrow & 2047;
#pragma unroll
                for (int s = 4; s < 6; ++s) {
                    const int pos = s == 4 ? (t >> 6) : (t & 63);
                    const f32x4 cs0 = *(const f32x4*)(ropeM + (pos * 8 + 4 * hh) * 2), cs1 = *(const f32x4*)(ropeM + (pos * 8 + 4 * hh + 2) * 2);
                    const u32x4 w = __builtin_bit_cast(u32x4, qf[s]);
                    u32x4 o;
                    { const float x1 = lo_bf(w.x), x2 = hi_bf(w.x); o.x = pk2(x1 * cs0.x - x2 * cs0.y, x2 * cs0.x + x1 * cs0.y); }
                    { const float x1 = lo_bf(w.y), x2 = hi_bf(w.y); o.y = pk2(x1 * cs0.z - x2 * cs0.w, x2 * cs0.z + x1 * cs0.w); }
                    { const float x1 = lo_bf(w.z), x2 = hi_bf(w.z); o.z = pk2(x1 * cs1.x - x2 * cs1.y, x2 * cs1.x + x1 * cs1.y); }
                    { const float x1 = lo_bf(w.w), x2 = hi_bf(w.w); o.w = pk2(x1 * cs1.z - x2 * cs1.w, x2 * cs1.z + x1 * cs1.w); }
                    qf[s] = __builtin_bit_cast(bf16x8, o);
                }
            }
        } else c_lane = 0.125f * LOG2E;
#pragma unroll
        for (int s = 0; s < NS; ++s) { const u32x4 w = __builtin_bit_cast(u32x4, qf[s]); u32x4 o;
            o.x = pk2(lo_bf(w.x) * c_lane, hi_bf(w.x) * c_lane); o.y = pk2(lo_bf(w.y) * c_lane, hi_bf(w.y) * c_lane);
            o.z = pk2(lo_bf(w.z) * c_lane, hi_bf(w.z) * c_lane); o.w = pk2(lo_bf(w.w) * c_lane, hi_bf(w.w) * c_lane); qf[s] = __builtin_bit_cast(bf16x8, o); }
    }
    float m2 = 0.f;
    if constexpr (!MLA) {
        float gq = fabsf(p.gqa_qn_g[l * 64 + lane]), gk = fabsf(p.gqa_kn_g[l * 64 + lane]);
#pragma unroll
        for (int o = 32; o > 0; o >>= 1) { gq = fmaxf(gq, shx(gq, o, lane)); gk = fmaxf(gk, shx(gk, o, lane)); }
        m2 = 64.f * gq * gk * 0.125f * LOG2E * 1.01f;
    }
    const int e0 = tid, e1 = tid + 512;
    const int k0key = e0 / CPR, k0c = e0 % CPR, k1key = e1 / CPR, k1c = e1 % CPR;
    const bool has1 = e1 < 64 * CPR;
    const int vkey = tid >> 3, vc8 = tid & 7;
    const int kw0 = k0key * KSTR + k0c * 16, kw1 = k1key * KSTR + k1c * 16, vw = (vc8 >> 2) * 4096 + vkey * 64 + (vc8 & 3) * 16;
    LAS unsigned char* Kl = lds; LAS unsigned char* Vl = lds + 2 * KBUF;
    const bool k0r = MLA && k0c >= 8, k1r = MLA && k1c >= 8;
    const bf16* ks0 = k0r ? KRsrc + (size_t)k0key * 32 + (k0c - 8) * 8 : Ksrc + (size_t)k0key * LDKV + k0c * 8;
    const bf16* ks1 = k1r ? KRsrc + (size_t)k1key * 32 + (k1c - 8) * 8 : Ksrc + (size_t)k1key * LDKV + k1c * 8;
    const int ks0s = k0r ? 32 : LDKV, ks1s = k1r ? 32 : LDKV;
    const bf16* vs0 = Vsrc + (size_t)vkey * LDKV + vc8 * 8;
    u32x4 kr0, kr1, vr;
    const int kt0 = ctxq ? 32 : 0, kt1 = 36;
#define MK_ROW0(kt) ((kt) < 32 ? b * 2048 + (kt) * 64 : NLAT + b * 256 + ((kt) - 32) * 64)
#define MK_SLOAD(kt) do { const int _r0 = MK_ROW0(kt); \
        kr0 = *(const u32x4*)(ks0 + (size_t)_r0 * ks0s); if (has1) kr1 = *(const u32x4*)(ks1 + (size_t)_r0 * ks1s); vr = *(const u32x4*)(vs0 + (size_t)_r0 * LDKV); } while (0)
#define MK_SWRITE(buf) do { *(LAS u32x4*)(Kl + (buf) * KBUF + kw0) = kr0; if (has1) *(LAS u32x4*)(Kl + (buf) * KBUF + kw1) = kr1; *(LAS u32x4*)(Vl + (buf) * VBUF + vw) = vr; } while (0)
    const int ka = r32 * KSTR + hh * 16;
    const unsigned vb0 = (unsigned)(uintptr_t)(Vl) + (unsigned)((4 * hh + ((lane & 15) >> 2)) * 64 + 32 * ((lane >> 4) & 1) + 8 * (lane & 3));
    f32x16 o0 = {}, o1 = {};
    float lsum = 0.f;
    f32x16 pA0, pA1, pB0, pB1;
    bf16x8 pb0, pb1, pb2, pb3;
#define MK_QK(P0, P1, kt) do { const float _nm = -m2; _Pragma("unroll") for (int r = 0; r < 16; ++r) { P0[r] = _nm; P1[r] = _nm; } const LAS unsigned char* kb = Kl + ((kt) & 1) * KBUF + ka; \
        _Pragma("unroll") for (int s = 0; s < NS; ++s) { const bf16x8 a0 = *(const LAS bf16x8*)(kb + s * 32), a1 = *(const LAS bf16x8*)(kb + 32 * KSTR + s * 32); \
            P0 = MK_MFMA32(a0, qf[s], P0); P1 = MK_MFMA32(a1, qf[s], P1); } } while (0)
#define MK_FINISH(P0, P1) do { f32x2 ps2 = {0.f, 0.f}; \
        _Pragma("unroll") for (int r = 0; r < 16; r += 2) { P0[r] = __builtin_amdgcn_exp2f(P0[r]); P0[r + 1] = __builtin_amdgcn_exp2f(P0[r + 1]); ps2 += (f32x2){P0[r], P0[r + 1]}; } \
        _Pragma("unroll") for (int r = 0; r < 16; r += 2) { P1[r] = __builtin_amdgcn_exp2f(P1[r]); P1[r + 1] = __builtin_amdgcn_exp2f(P1[r + 1]); ps2 += (f32x2){P1[r], P1[r + 1]}; } \
        lsum += ps2.x + ps2.y; pb0 = pack8(P0, 0); pb1 = pack8(P0, 8); pb2 = pack8(P1, 0); pb3 = pack8(P1, 8); } while (0)
#define MK_PV(kt) do { const unsigned vb = vb0 + ((kt) % 3) * VBUF; pv_one<0>(o0, vb, pb0, pb1, pb2, pb3); pv_one<1>(o1, vb, pb0, pb1, pb2, pb3); } while (0)
#define MK_DECIDE(P0, P1) do { if constexpr (MLA) { float tmax = P0[0]; \
        _Pragma("unroll") for (int r = 1; r < 16; ++r) tmax = fmaxf(tmax, P0[r]); \
        _Pragma("unroll") for (int r = 0; r < 16; ++r) tmax = fmaxf(tmax, P1[r]); \
        { const auto rr = __builtin_amdgcn_permlane32_swap(__float_as_uint(tmax), __float_as_uint(tmax), false, false); tmax = fmaxf(__uint_as_float(rr[0]), __uint_as_float(rr[1])); } \
        if (__any(tmax > THR2)) { const float dm = fmaxf(tmax, 0.f), alpha = __builtin_amdgcn_exp2f(-dm); m2 += dm; lsum *= alpha; \
            _Pragma("unroll") for (int r = 0; r < 16; ++r) { o0[r] *= alpha; o1[r] *= alpha; P0[r] -= dm; P1[r] -= dm; } } } } while (0)
#define MK_SWRITE3(t) do { *(LAS u32x4*)(Kl + ((t) & 1) * KBUF + kw0) = kr0; if (has1) *(LAS u32x4*)(Kl + ((t) & 1) * KBUF + kw1) = kr1; *(LAS u32x4*)(Vl + ((t) % 3) * VBUF + vw) = vr; } while (0)
#define MK_ITER(j, C0, C1, R0_, R1_) do { const int _t = kt0 + (j); if ((j) + 1 < NT_) MK_SLOAD(_t + 1); \
        MK_QK(C0, C1, _t); MK_FINISH(R0_, R1_); MK_PV(_t - 1); MK_DECIDE(C0, C1); \
        if ((j) + 1 < NT_) MK_SWRITE3(_t + 1); __syncthreads(); } while (0)
    const int NT_ = kt1 - kt0;
    MK_SLOAD(kt0);
    __syncthreads();
    MK_SWRITE3(kt0);
    MK_SLOAD(kt0 + 1);
    __syncthreads();
    MK_QK(pA0, pA1, kt0); MK_DECIDE(pA0, pA1);
    MK_SWRITE3(kt0 + 1);
    __syncthreads();
    for (int j = 1; j + 1 < NT_; j += 2) {
        MK_ITER(j, pB0, pB1, pA0, pA1);
        MK_ITER(j + 1, pA0, pA1, pB0, pB1);
    }
    bf16* gp = (bf16*)(p.ws + WS_GATE) + (size_t)qrow * 1024 + (MLA ? 0 : 384) + h * 64 + 8 * hh;
    u32x4 gv[2][2];
#pragma unroll
    for (int tl = 0; tl < 2; ++tl)
#pragma unroll
        for (int pr = 0; pr < 2; ++pr) gv[tl][pr] = *(const u32x4*)(gp + 32 * tl + 16 * pr);
    MK_ITER(NT_ - 1, pB0, pB1, pA0, pA1);
    MK_FINISH(pB0, pB1); MK_PV(kt1 - 1);
#undef MK_QK
#undef MK_FINISH
#undef MK_PV
#undef MK_DECIDE
#undef MK_SWRITE3
#undef MK_ITER
    { const auto rr = __builtin_amdgcn_permlane32_swap(__float_as_uint(lsum), __float_as_uint(lsum), false, false); lsum = __uint_as_float(rr[0]) + __uint_as_float(rr[1]); }
    const float inv = 1.f / lsum;
#pragma unroll
    for (int tl = 0; tl < 2; ++tl)
#pragma unroll
        for (int pr = 0; pr < 2; ++pr) {
            float v[8];
#pragma unroll
            for (int e = 0; e < 4; ++e) {
                const float lo = tl ? o1[8 * pr + e] : o0[8 * pr + e], hi = tl ? o1[8 * pr + 4 + e] : o0[8 * pr + 4 + e];
                const auto rr = __builtin_amdgcn_permlane32_swap(__float_as_uint(lo), __float_as_uint(hi), false, false);
                v[e] = __uint_as_float(rr[0]); v[4 + e] = __uint_as_float(rr[1]);
            }
            const u32x4 gw = gv[tl][pr];
            u32x4 ow;
            ow.x = pk2(v[0] * inv * siluf(lo_bf(gw.x)), v[1] * inv * siluf(hi_bf(gw.x))); ow.y = pk2(v[2] * inv * siluf(lo_bf(gw.y)), v[3] * inv * siluf(hi_bf(gw.y)));
            ow.z = pk2(v[4] * inv * siluf(lo_bf(gw.z)), v[5] * inv * siluf(hi_bf(gw.z))); ow.w = pk2(v[6] * inv * siluf(lo_bf(gw.w)), v[7] * inv * siluf(hi_bf(gw.w)));
            *(u32x4*)(gp + 32 * tl + 16 * pr) = ow;
        }
#undef MK_ROW0
#undef MK_SLOAD
#undef MK_SWRITE
}

typedef short v4i16_t __attribute__((ext_vector_type(4)));
DI s16x4 vtr_(const LAS unsigned char* p) { return __builtin_bit_cast(s16x4, __builtin_amdgcn_ds_read_tr16_b64_v4i16((LAS v4i16_t*)p)); }
DI void glds16(const void* g, unsigned lds_base) {
    unsigned sv; asm volatile("s_mov_b32 %0, m0\n\ts_mov_b32 m0, %2\n\ts_nop 0\n\tglobal_load_lds_dwordx4 %1, off\n\ts_mov_b32 m0, %0" : "=&s"(sv) : "v"(g), "s"(lds_base) : "memory"); }
#define MK_WAIT_BAR(N) asm volatile("s_waitcnt vmcnt(" #N ") lgkmcnt(0)\n\ts_barrier" ::: "memory")
DI void attn_unit_g(const Ptrs& p, int l, LAS unsigned char* lds, int b, int h, int qb, bool ctxq, int tid) {
    asm volatile("" : "+v"(tid));
    constexpr float LOG2E = 1.4426950408889634f;
    constexpr int PK_ = 128, SLOTB = 8192, LDS_K = 0, LDS_V = 3 * SLOTB;
    const int lane = tid & 63, r32 = lane & 31, hi = lane >> 5; const int wid = __builtin_amdgcn_readfirstlane(tid >> 6);
    const int qrow = (ctxq ? NLAT + b * 256 : b * 2048 + qb * 256) + wid * 32 + r32;
    const int hk = h / 3;
    const bf16* Ksrc = (const bf16*)(p.ws + WS_GK) + hk * 64; const bf16* Vsrc = (const bf16*)(p.ws + WS_GV) + hk * 64;
    const unsigned lds0 = (unsigned)(uintptr_t)lds;
    const bf16* ksrc = Ksrc + (size_t)lane * PK_ + wid * 8;
    const bf16* vsrc = Vsrc + (size_t)(16 * (wid & 3) + (lane >> 2)) * PK_ + (wid >> 2) * 32 + (lane & 3) * 8;
    const unsigned kdst = lds0 + LDS_K + wid * 1024, vdst = lds0 + LDS_V + wid * 1024;
    const int kt0 = ctxq ? 32 : 0, NT = 36 - kt0;
#define MK_GROW0(t) (((t) + kt0) < 32 ? b * 2048 + ((t) + kt0) * 64 : NLAT + b * 256 + ((t) + kt0 - 32) * 64)
#define DMA_K(t, slot) glds16(ksrc + (size_t)MK_GROW0(t) * PK_, (unsigned)__builtin_amdgcn_readfirstlane(kdst + (slot)))
#define DMA_V(t, slot) glds16(vsrc + (size_t)MK_GROW0(t) * PK_, (unsigned)__builtin_amdgcn_readfirstlane(vdst + (slot)))
    const LAS unsigned char* kp0 = lds + LDS_K + hi * 1024 + r32 * 16;
    const LAS unsigned char* vp0 = lds + LDS_V + ((lane >> 4) & 1) * 32 + (lane & 3) * 8 + (4 * hi + ((lane & 15) >> 2)) * 64;
    const unsigned vb0u = lds0 + LDS_V + (unsigned)(((lane >> 4) & 1) * 32 + (lane & 3) * 8 + (4 * hi + ((lane & 15) >> 2)) * 64);
    bf16x8 kf[8];
    DMA_K(0, 0); DMA_V(0, 0); DMA_K(1, SLOTB);
    bf16x8 qr[4];
    {
        const bf16* qp = (const bf16*)(p.ws + WS_GQ) + (size_t)qrow * 384 + h * 64 + hi * 8;
#pragma unroll
        for (int s = 0; s < 4; ++s) qr[s] = *(const bf16x8*)(qp + 16 * s);
        const float c_lane = 0.125f * LOG2E;
#pragma unroll
        for (int s = 0; s < 4; ++s) { const u32x4 w = __builtin_bit_cast(u32x4, qr[s]); u32x4 o;
            o.x = pk2(lo_bf(w.x) * c_lane, hi_bf(w.x) * c_lane); o.y = pk2(lo_bf(w.y) * c_lane, hi_bf(w.y) * c_lane);
            o.z = pk2(lo_bf(w.z) * c_lane, hi_bf(w.z) * c_lane); o.w = pk2(lo_bf(w.w) * c_lane, hi_bf(w.w) * c_lane); qr[s] = __builtin_bit_cast(bf16x8, o); }
    }
    f32x16 negm;
    {
        float gq = fabsf(p.gqa_qn_g[l * 64 + lane]), gk = fabsf(p.gqa_kn_g[l * 64 + lane]);
#pragma unroll
        for (int o = 32; o > 0; o >>= 1) { gq = fmaxf(gq, shx(gq, o, lane)); gk = fmaxf(gk, shx(gk, o, lane)); }
        const float nm = -(64.f * gq * gk * 0.125f * LOG2E * 1.01f);
#pragma unroll
        for (int r = 0; r < 16; ++r) negm[r] = nm;
        asm volatile("" : "+v"(negm));
    }
    f32x16 o0 = {}, o1 = {}; float l_reg = 0.f;
    f32x16 pA0, pA1, pB0, pB1;
    int sl_prev = 0, sl_cur = 0, sl_next = SLOTB;
#define ROT() do { sl_prev = sl_cur; sl_cur = sl_next; sl_next = (sl_next == 2 * SLOTB) ? 0 : sl_next + SLOTB; } while (0)
    DMA_K(2, 2 * SLOTB);
    MK_WAIT_BAR(3);
    {
#pragma unroll
        for (int d0 = 0; d0 < 4; ++d0) {
            const bf16x8 b0 = *(const LAS bf16x8*)(kp0 + d0 * 2048), b1 = *(const LAS bf16x8*)(kp0 + d0 * 2048 + 512);
            if (d0 == 0) { pA0 = MK_MFMA32(b0, qr[0], negm); pA1 = MK_MFMA32(b1, qr[0], negm); }
            else { pA0 = MK_MFMA32(b0, qr[d0], pA0); pA1 = MK_MFMA32(b1, qr[d0], pA1); }
        }
#pragma unroll
        for (int r = 0; r < 16; ++r) { pA0[r] = __builtin_amdgcn_exp2f(pA0[r]); pA1[r] = __builtin_amdgcn_exp2f(pA1[r]); }
    }
    MK_WAIT_BAR(0);
    DMA_K(3, 0); DMA_V(1, SLOTB);
    ROT();
#define KLOAD2(kp, j) do { kf[2 * (j)] = *(const LAS bf16x8*)((kp) + (j) * 2048); kf[2 * (j) + 1] = *(const LAS bf16x8*)((kp) + (j) * 2048 + 512); } while (0)
    { const LAS unsigned char* kp = kp0 + sl_cur; KLOAD2(kp, 0); KLOAD2(kp, 1); KLOAD2(kp, 2); KLOAD2(kp, 3); }
    MK_WAIT_BAR(2);
    s16x4 vlo[8], vhi[8]; u32x4 pw0, pw1, pw2, pw3;
#define PKW(P, B) pk2(P[B], P[(B) + 1])
#define PAF(k) __builtin_bit_cast(bf16x8, pw##k)
#define VFR(i) (bf16x8){vlo[i][0], vlo[i][1], vlo[i][2], vlo[i][3], vhi[i][0], vhi[i][1], vhi[i][2], vhi[i][3]}
#define PIN(x) asm volatile("" : "+v"(x))
#define SBAR_() __builtin_amdgcn_sched_barrier(0)
#define GAPA(MF, A0, A1, A2, A3, W0, W1, PW) do { MF; sacc += A0; sacc += A1; sacc += A2; sacc += A3; PIN(sacc); W0; W1; PIN(PW); SBAR_(); } while (0)
#define EX_(v) __builtin_amdgcn_exp2f(v)
#define GAPB(MF, X, B) do { MF; X[B] = EX_(X[B]); X[(B) + 1] = EX_(X[(B) + 1]); X[(B) + 2] = EX_(X[(B) + 2]); X[(B) + 3] = EX_(X[(B) + 3]); PIN(X); SBAR_(); } while (0)
#define VRD(i) do { vlo[i] = vtr_(vp_ + (((i) >> 2) * 4096 + ((i) & 3) * 1024)); vhi[i] = vtr_(vp_ + (((i) >> 2) * 4096 + ((i) & 3) * 1024 + 512)); } while (0)
#define KRD(G, j) do { if (G) { KLOAD2(kp0 + sl_next, j); SBAR_(); } } while (0)
#define STEP(C0, C1, P0, P1, t, GK, GV, GL) do { SBAR_(); \
    const LAS unsigned char* vp_ = vp0 + sl_prev; \
    VRD(0); SBAR_(); float sacc = (P0[0] + P0[1]); \
    GAPA(C0 = MK_MFMA32(kf[0], qr[0], negm), P0[2], P0[3], P0[4], P0[5],     pw0[0] = PKW(P0, 0), pw0[1] = PKW(P0, 2), pw0); \
    VRD(4); SBAR_(); GAPA(C1 = MK_MFMA32(kf[1], qr[0], negm), P0[6], P0[7], P0[8], P0[9],     pw0[2] = PKW(P0, 4), pw0[3] = PKW(P0, 6), pw0); \
    VRD(1); SBAR_(); GAPA(C0 = MK_MFMA32(kf[2], qr[1], C0),   P0[10], P0[11], P0[12], P0[13], pw1[0] = PKW(P0, 8), pw1[1] = PKW(P0, 10), pw1); \
    VRD(5); SBAR_(); GAPA(C1 = MK_MFMA32(kf[3], qr[1], C1),   P0[14], P0[15], P1[0], P1[1],   pw1[2] = PKW(P0, 12), pw1[3] = PKW(P0, 14), pw1); \
    VRD(2); SBAR_(); GAPA(C0 = MK_MFMA32(kf[4], qr[2], C0),   P1[2], P1[3], P1[4], P1[5],     pw2[0] = PKW(P1, 0), pw2[1] = PKW(P1, 2), pw2); \
    VRD(6); SBAR_(); GAPA(C1 = MK_MFMA32(kf[5], qr[2], C1),   P1[6], P1[7], P1[8], P1[9],     pw2[2] = PKW(P1, 4), pw2[3] = PKW(P1, 6), pw2); \
    VRD(3); SBAR_(); GAPA(C0 = MK_MFMA32(kf[6], qr[3], C0),   P1[10], P1[11], P1[12], P1[13], pw3[0] = PKW(P1, 8), pw3[1] = PKW(P1, 10), pw3); \
    VRD(7); SBAR_(); GAPA(C1 = MK_MFMA32(kf[7], qr[3], C1),   P1[14], P1[15], 0.f, 0.f,       pw3[2] = PKW(P1, 12), pw3[3] = PKW(P1, 14), pw3); \
    l_reg += sacc; \
    if (GK) { DMA_K((t) + 3, sl_cur); } if (GV) { DMA_V((t) + 1, sl_next); } \
    SBAR_(); \
    GAPB(o0 = MK_MFMA32(VFR(0), PAF(0), o0), C0, 0); \
    GAPB(o1 = MK_MFMA32(VFR(4), PAF(0), o1), C0, 4); \
    KRD(GL, 0); GAPB(o0 = MK_MFMA32(VFR(1), PAF(1), o0), C0, 8); \
    KRD(GL, 1); GAPB(o1 = MK_MFMA32(VFR(5), PAF(1), o1), C0, 12); \
    KRD(GL, 2); GAPB(o0 = MK_MFMA32(VFR(2), PAF(2), o0), C1, 0); \
    KRD(GL, 3); GAPB(o1 = MK_MFMA32(VFR(6), PAF(2), o1), C1, 4); \
    GAPB(o0 = MK_MFMA32(VFR(3), PAF(3), o0), C1, 8); \
    GAPB(o1 = MK_MFMA32(VFR(7), PAF(3), o1), C1, 12); \
    } while (0)
    int t = 1;
    for (; t + 5 < NT; t += 2) {
        STEP(pB0, pB1, pA0, pA1, t, true, true, true);     MK_WAIT_BAR(2); ROT();
        STEP(pA0, pA1, pB0, pB1, t + 1, true, true, true); MK_WAIT_BAR(2); ROT();
    }
#define ENDW(tt) do { if ((tt) + 3 < NT) { MK_WAIT_BAR(2); } else if ((tt) + 2 < NT) { MK_WAIT_BAR(1); } else { MK_WAIT_BAR(0); } } while (0)
    for (; t + 1 < NT; t += 2) {
        STEP(pB0, pB1, pA0, pA1, t, (t + 3 < NT), (t + 1 < NT), (t + 1 < NT));         ENDW(t);     ROT();
        STEP(pA0, pA1, pB0, pB1, t + 1, (t + 4 < NT), (t + 2 < NT), (t + 2 < NT));     ENDW(t + 1); ROT();
    }
    STEP(pB0, pB1, pA0, pA1, NT - 1, false, false, false);
    {
        float sacc = pB0[0] + pB0[1];
#pragma unroll
        for (int r = 2; r < 16; ++r) sacc += pB0[r];
#pragma unroll
        for (int r = 0; r < 16; ++r) sacc += pB1[r];
        l_reg += sacc;
        const bf16x8 b0 = pack8(pB0, 0), b1 = pack8(pB0, 8), b2 = pack8(pB1, 0), b3 = pack8(pB1, 8);
        SBAR_();
        const unsigned vb = vb0u + (unsigned)sl_cur;
        pv_one<0>(o0, vb, b0, b1, b2, b3); pv_one<1>(o1, vb, b0, b1, b2, b3);
    }
#undef PKW
#undef PAF
#undef VFR
#undef PIN
#undef GAPA
#undef GAPB
#undef EX_
#undef VRD
#undef KRD
#undef STEP
#undef ENDW
#undef KLOAD2
#undef ROT
#undef DMA_K
#undef DMA_V
#undef MK_GROW0
    { const auto rr = __builtin_amdgcn_permlane32_swap(__float_as_uint(l_reg), __float_as_uint(l_reg), false, false); l_reg = __uint_as_float(rr[0]) + __uint_as_float(rr[1]); }
    const float inv = 1.f / l_reg;
    bf16* gp = (bf16*)(p.ws + WS_GATE) + (size_t)qrow * 1024 + 384 + h * 64 + 8 * hi;
#pragma unroll
    for (int tl = 0; tl < 2; ++tl)
#pragma unroll
        for (int pr = 0; pr < 2; ++pr) {
            const u32x4 gw = *(const u32x4*)(gp + 32 * tl + 16 * pr);
            float v[8];
#pragma unroll
            for (int e = 0; e < 4; ++e) {
                const float lo = tl ? o1[8 * pr + e] : o0[8 * pr + e], hi_ = tl ? o1[8 * pr + 4 + e] : o0[8 * pr + 4 + e];
                const auto rr = __builtin_amdgcn_permlane32_swap(__float_as_uint(lo), __float_as_uint(hi_), false, false);
                v[e] = __uint_as_float(rr[0]); v[4 + e] = __uint_as_float(rr[1]);
            }
            u32x4 ow;
            ow.x = pk2(v[0] * inv * siluf(lo_bf(gw.x)), v[1] * inv * siluf(hi_bf(gw.x))); ow.y = pk2(v[2] * inv * siluf(lo_bf(gw.y)), v[3] * inv * siluf(hi_bf(gw.y)));
            ow.z = pk2(v[4] * inv * siluf(lo_bf(gw.z)), v[5] * inv * siluf(hi_bf(gw.z))); ow.w = pk2(v[6] * inv * siluf(lo_bf(gw.w)), v[7] * inv * siluf(hi_bf(gw.w)));
            *(u32x4*)(gp + 32 * tl + 16 * pr) = ow;
        }
    asm volatile("s_waitcnt lgkmcnt(0)\n\ts_barrier" ::: "memory");
}
DI int attn_lane_() { int ln; asm volatile("v_mbcnt_lo_u32_b32 %0, -1, 0\n\tv_mbcnt_hi_u32_b32 %0, -1, %0" : "=v"(ln)); return ln; }
DI void attn_unit_m(const Ptrs& p, int l, LAS unsigned char* lds, int b, int h, int qb, bool ctxq, int tid) {
    asm volatile("" : "+v"(tid));
    constexpr float LOG2E = 1.4426950408889634f, THR2 = 8.f * LOG2E;
    constexpr int PK_ = 768, KSLOT = 12288, VSLOT = 8192, LDS_K = 0, LDS_V = 3 * KSLOT;
    const int lane = tid & 63, r32 = lane & 31, hi = lane >> 5; const int wid = __builtin_amdgcn_readfirstlane(tid >> 6);
    const int qrow = (ctxq ? NLAT + b * 256 : b * 2048 + qb * 256) + wid * 32 + r32;
    const bf16* Ksrc = (const bf16*)(p.ws + WS_KVMLA) + h * 128; const bf16* Vsrc = (const bf16*)(p.ws + WS_KVMLA) + h * 128 + 64; const bf16* KRsrc = (const bf16*)(p.ws + WS_KR);
    const unsigned lds0 = (unsigned)(uintptr_t)lds;
    const unsigned koff = (unsigned)(lane * PK_ + wid * 8) * 2u, kroff = (unsigned)(lane * 32 + (wid & 3) * 8) * 2u;
    const unsigned voff = (unsigned)((16 * (wid & 3) + (lane >> 2)) * PK_ + (wid >> 2) * 32 + (lane & 3) * 8) * 2u;
    const unsigned kdst = lds0 + LDS_K + wid * 1024, krdst = lds0 + LDS_K + (8 + (wid & 3)) * 1024, vdst = lds0 + LDS_V + wid * 1024;
    const int kt0 = ctxq ? 32 : 0, NT = 36 - kt0;
#define MK_GROW0(t) (((t) + kt0) < 32 ? b * 2048 + ((t) + kt0) * 64 : NLAT + b * 256 + ((t) + kt0 - 32) * 64)
#define DMA_K(t, si) do { const int _r0 = MK_GROW0(t); glds16((const char*)Ksrc + (size_t)_r0 * (PK_ * 2) + koff, (unsigned)__builtin_amdgcn_readfirstlane(kdst + (si) * KSLOT)); \
        glds16((const char*)KRsrc + (size_t)_r0 * 64 + kroff, (unsigned)__builtin_amdgcn_readfirstlane(krdst + (si) * KSLOT)); } while (0)
#define DMA_V(t, si) glds16((const char*)Vsrc + (size_t)MK_GROW0(t) * (PK_ * 2) + voff, (unsigned)__builtin_amdgcn_readfirstlane(vdst + (si) * VSLOT))
    const LAS unsigned char* kp0 = lds + LDS_K + hi * 1024 + r32 * 16;
    const LAS unsigned char* vp0 = lds + LDS_V + ((lane >> 4) & 1) * 32 + (lane & 3) * 8 + (4 * hi + ((lane & 15) >> 2)) * 64;
    bf16x8 kf[12];
    DMA_K(0, 0); DMA_V(0, 0); DMA_K(1, 1);
    bf16x8 qr[6];
    {
        const bf16* qp = (const bf16*)(p.ws + WS_QMLA) + (size_t)qrow * 576 + h * 96 + hi * 8;
#pragma unroll
        for (int s = 0; s < 6; ++s) qr[s] = *(const bf16x8*)(qp + 16 * s);
        const float ssq = ((const float*)(p.ws + CTL_SSQ))[(size_t)l * 2 * M + qrow];
        const float c_lane = 0.10206207261596577f * LOG2E / sqrtf(ssq * (1.f / 384.f) + EPS);
        if (!ctxq) {
            const float* ropeM = (const float*)(p.ws + WS_ROPE + ROPE_M_OFF);
            const int t = qrow & 2047;
#pragma unroll
            for (int s = 4; s < 6; ++s) {
                const int pos = s == 4 ? (t >> 6) : (t & 63);
                const f32x4 cs0 = *(const f32x4*)(ropeM + (pos * 8 + 4 * hi) * 2), cs1 = *(const f32x4*)(ropeM + (pos * 8 + 4 * hi + 2) * 2);
                const u32x4 w = __builtin_bit_cast(u32x4, qr[s]);
                u32x4 o;
                { const float x1 = lo_bf(w.x), x2 = hi_bf(w.x); o.x = pk2(x1 * cs0.x - x2 * cs0.y, x2 * cs0.x + x1 * cs0.y); }
                { const float x1 = lo_bf(w.y), x2 = hi_bf(w.y); o.y = pk2(x1 * cs0.z - x2 * cs0.w, x2 * cs0.z + x1 * cs0.w); }
                { const float x1 = lo_bf(w.z), x2 = hi_bf(w.z); o.z = pk2(x1 * cs1.x - x2 * cs1.y, x2 * cs1.x + x1 * cs1.y); }
                { const float x1 = lo_bf(w.w), x2 = hi_bf(w.w); o.w = pk2(x1 * cs1.z - x2 * cs1.w, x2 * cs1.z + x1 * cs1.w); }
                qr[s] = __builtin_bit_cast(bf16x8, o);
            }
        }
#pragma unroll
        for (int s = 0; s < 6; ++s) { const u32x4 w = __builtin_bit_cast(u32x4, qr[s]); u32x4 o;
            o.x = pk2(lo_bf(w.x) * c_lane, hi_bf(w.x) * c_lane); o.y = pk2(lo_bf(w.y) * c_lane, hi_bf(w.y) * c_lane);
            o.z = pk2(lo_bf(w.z) * c_lane, hi_bf(w.z) * c_lane); o.w = pk2(lo_bf(w.w) * c_lane, hi_bf(w.w) * c_lane); qr[s] = __builtin_bit_cast(bf16x8, o); }
    }
    float mhat = 0.f, l_reg = 0.f, alpha = 1.f; bool resc = false;
    f32x16 negm = {}; asm volatile("" : "+v"(negm));
    f32x16 o0 = {}, o1 = {};
    f32x16 pA0, pA1, pB0, pB1;
    int si_prev = 0, si_cur = 0, si_next = 1;
#define ROT() do { si_prev = si_cur; si_cur = si_next; si_next = (si_next == 2) ? 0 : si_next + 1; } while (0)
#define MX3(a, b, c) __builtin_fmaxf(__builtin_fmaxf((a), (b)), (c))
#define DECIDE(C0, C1) do { float a_ = MX3(C0[0], C0[1], C1[0]), b_ = MX3(C0[2], C0[3], C1[1]); a_ = MX3(a_, C1[2], C1[3]); \
        _Pragma("unroll") for (int r = 4; r < 16; r += 4) { a_ = MX3(a_, C0[r], C0[r + 1]); b_ = MX3(b_, C0[r + 2], C0[r + 3]); a_ = MX3(a_, C1[r], C1[r + 1]); b_ = MX3(b_, C1[r + 2], C1[r + 3]); } \
        float rm = __builtin_fmaxf(a_, b_); { const auto rr = __builtin_amdgcn_permlane32_swap(__float_as_uint(rm), __float_as_uint(rm), false, false); rm = __builtin_fmaxf(__uint_as_float(rr[0]), __uint_as_float(rr[1])); } \
        resc = false; \
        if (__builtin_expect(__any(rm > THR2), 0)) { const float dl = __builtin_fmaxf(rm, 0.f); mhat += dl; \
            _Pragma("unroll") for (int r = 0; r < 16; ++r) { C0[r] -= dl; C1[r] -= dl; } \
            _Pragma("unroll") for (int r = 0; r < 16; ++r) negm[r] = -mhat; asm volatile("" : "+v"(negm)); \
            alpha = __builtin_amdgcn_exp2f(-dl); l_reg *= alpha; resc = true; } } while (0)
#define RESC() do { if (resc) { _Pragma("unroll") for (int r = 0; r < 16; ++r) { o0[r] *= alpha; o1[r] *= alpha; } } } while (0)
    DMA_K(2, 2);
    MK_WAIT_BAR(5);
    {
#pragma unroll
        for (int d0 = 0; d0 < 6; ++d0) {
            const bf16x8 b0 = *(const LAS bf16x8*)(kp0 + d0 * 2048), b1 = *(const LAS bf16x8*)(kp0 + d0 * 2048 + 512);
            if (d0 == 0) { pA0 = MK_MFMA32(b0, qr[0], negm); pA1 = MK_MFMA32(b1, qr[0], negm); }
            else { pA0 = MK_MFMA32(b0, qr[d0], pA0); pA1 = MK_MFMA32(b1, qr[d0], pA1); }
        }
        DECIDE(pA0, pA1);
#pragma unroll
        for (int r = 0; r < 16; ++r) { pA0[r] = __builtin_amdgcn_exp2f(pA0[r]); pA1[r] = __builtin_amdgcn_exp2f(pA1[r]); }
    }
    MK_WAIT_BAR(0);
    DMA_K(3, 0); DMA_V(1, 1);
    ROT();
#define KLOAD2(kp, j) do { kf[2 * (j)] = *(const LAS bf16x8*)((kp) + (j) * 2048); kf[2 * (j) + 1] = *(const LAS bf16x8*)((kp) + (j) * 2048 + 512); } while (0)
    { const LAS unsigned char* kp = kp0 + si_cur * KSLOT; KLOAD2(kp, 0); KLOAD2(kp, 1); KLOAD2(kp, 2); KLOAD2(kp, 3); KLOAD2(kp, 4); KLOAD2(kp, 5); }
    MK_WAIT_BAR(3);
    s16x4 vlo[8], vhi[8]; u32x4 pw0, pw1, pw2, pw3;
#define PKW(P, B) pk2(P[B], P[(B) + 1])
#define PAF(k) __builtin_bit_cast(bf16x8, pw##k)
#define VFR(i) (bf16x8){vlo[i][0], vlo[i][1], vlo[i][2], vlo[i][3], vhi[i][0], vhi[i][1], vhi[i][2], vhi[i][3]}
#define PIN(x) asm volatile("" : "+v"(x))
#define SBAR_() __builtin_amdgcn_sched_barrier(0)
#define GAPA(MF, A0, A1, A2, A3, W0, W1, PW) do { MF; sacc += A0; sacc += A1; sacc += A2; sacc += A3; PIN(sacc); W0; W1; PIN(PW); SBAR_(); } while (0)
#define GAPM(MF) do { MF; SBAR_(); } while (0)
#define EX_(v) __builtin_amdgcn_exp2f(v)
#define GAPB(MF, X, B) do { MF; X[B] = EX_(X[B]); X[(B) + 1] = EX_(X[(B) + 1]); X[(B) + 2] = EX_(X[(B) + 2]); X[(B) + 3] = EX_(X[(B) + 3]); PIN(X); SBAR_(); } while (0)
#define VRD(i) do { vlo[i] = vtr_(vp_ + (((i) >> 2) * 4096 + ((i) & 3) * 1024)); vhi[i] = vtr_(vp_ + (((i) >> 2) * 4096 + ((i) & 3) * 1024 + 512)); } while (0)
#define KRD(G, j) do { if (G) { KLOAD2(kp0 + si_next * KSLOT, j); SBAR_(); } } while (0)
#define STEP(C0, C1, P0, P1, t, GK, GV, GL) do { SBAR_(); \
    const LAS unsigned char* vp_ = vp0 + si_prev * VSLOT; \
    VRD(0); SBAR_(); float sacc = (P0[0] + P0[1]); \
    GAPA(C0 = MK_MFMA32(kf[0], qr[0], negm), P0[2], P0[3], P0[4], P0[5],     pw0[0] = PKW(P0, 0), pw0[1] = PKW(P0, 2), pw0); \
    VRD(4); SBAR_(); GAPA(C1 = MK_MFMA32(kf[1], qr[0], negm), P0[6], P0[7], P0[8], P0[9],     pw0[2] = PKW(P0, 4), pw0[3] = PKW(P0, 6), pw0); \
    VRD(1); SBAR_(); GAPA(C0 = MK_MFMA32(kf[2], qr[1], C0),   P0[10], P0[11], P0[12], P0[13], pw1[0] = PKW(P0, 8), pw1[1] = PKW(P0, 10), pw1); \
    VRD(5); SBAR_(); GAPA(C1 = MK_MFMA32(kf[3], qr[1], C1),   P0[14], P0[15], P1[0], P1[1],   pw1[2] = PKW(P0, 12), pw1[3] = PKW(P0, 14), pw1); \
    VRD(2); SBAR_(); GAPA(C0 = MK_MFMA32(kf[4], qr[2], C0),   P1[2], P1[3], P1[4], P1[5],     pw2[0] = PKW(P1, 0), pw2[1] = PKW(P1, 2), pw2); \
    VRD(6); SBAR_(); GAPA(C1 = MK_MFMA32(kf[5], qr[2], C1),   P1[6], P1[7], P1[8], P1[9],     pw2[2] = PKW(P1, 4), pw2[3] = PKW(P1, 6), pw2); \
    VRD(3); SBAR_(); GAPA(C0 = MK_MFMA32(kf[6], qr[3], C0),   P1[10], P1[11], P1[12], P1[13], pw3[0] = PKW(P1, 8), pw3[1] = PKW(P1, 10), pw3); \
    VRD(7); SBAR_(); GAPA(C1 = MK_MFMA32(kf[7], qr[3], C1),   P1[14], P1[15], 0.f, 0.f,       pw3[2] = PKW(P1, 12), pw3[3] = PKW(P1, 14), pw3); \
    GAPM(C0 = MK_MFMA32(kf[8], qr[4], C0)); GAPM(C1 = MK_MFMA32(kf[9], qr[4], C1)); GAPM(C0 = MK_MFMA32(kf[10], qr[5], C0)); GAPM(C1 = MK_MFMA32(kf[11], qr[5], C1)); \
    l_reg += sacc; \
    if (GK) { DMA_K((t) + 3, si_cur); } if (GV) { DMA_V((t) + 1, si_next); } \
    DECIDE(C0, C1); \
    SBAR_(); \
    GAPB(o0 = MK_MFMA32(VFR(0), PAF(0), o0), C0, 0); \
    GAPB(o1 = MK_MFMA32(VFR(4), PAF(0), o1), C0, 4); \
    KRD(GL, 0); GAPB(o0 = MK_MFMA32(VFR(1), PAF(1), o0), C0, 8); \
    KRD(GL, 1); GAPB(o1 = MK_MFMA32(VFR(5), PAF(1), o1), C0, 12); \
    KRD(GL, 2); GAPB(o0 = MK_MFMA32(VFR(2), PAF(2), o0), C1, 0); \
    KRD(GL, 3); GAPB(o1 = MK_MFMA32(VFR(6), PAF(2), o1), C1, 4); \
    KRD(GL, 4); GAPB(o0 = MK_MFMA32(VFR(3), PAF(3), o0), C1, 8); \
    KRD(GL, 5); GAPB(o1 = MK_MFMA32(VFR(7), PAF(3), o1), C1, 12); \
    } while (0)
    int t = 1;
    for (; t + 5 < NT; t += 2) {
        STEP(pB0, pB1, pA0, pA1, t, true, true, true);     MK_WAIT_BAR(3); RESC(); ROT();
        STEP(pA0, pA1, pB0, pB1, t + 1, true, true, true); MK_WAIT_BAR(3); RESC(); ROT();
    }
#define ENDW(tt) do { if ((tt) + 3 < NT) { MK_WAIT_BAR(3); } else if ((tt) + 2 < NT) { MK_WAIT_BAR(1); } else { MK_WAIT_BAR(0); } } while (0)
    for (; t + 1 < NT; t += 2) {
        STEP(pB0, pB1, pA0, pA1, t, (t + 3 < NT), (t + 1 < NT), (t + 1 < NT));         ENDW(t);     RESC(); ROT();
        STEP(pA0, pA1, pB0, pB1, t + 1, (t + 4 < NT), (t + 2 < NT), (t + 2 < NT));     ENDW(t + 1); RESC(); ROT();
    }
    STEP(pB0, pB1, pA0, pA1, NT - 1, false, false, false); RESC();
    {
        float sacc = pB0[0] + pB0[1];
#pragma unroll
        for (int r = 2; r < 16; ++r) sacc += pB0[r];
#pragma unroll
        for (int r = 0; r < 16; ++r) sacc += pB1[r];
        l_reg += sacc;
        const bf16x8 b0 = pack8(pB0, 0), b1 = pack8(pB0, 8), b2 = pack8(pB1, 0), b3 = pack8(pB1, 8);
        SBAR_();
        const int ln_ = attn_lane_();
        const unsigned vb = lds0 + LDS_V + (unsigned)(((ln_ >> 4) & 1) * 32 + (ln_ & 3) * 8 + (4 * (ln_ >> 5) + ((ln_ & 15) >> 2)) * 64) + (unsigned)(si_cur * VSLOT);
        pv_one<0>(o0, vb, b0, b1, b2, b3); pv_one<1>(o1, vb, b0, b1, b2, b3);
    }
#undef PKW
#undef PAF
#undef VFR
#undef PIN
#undef GAPA
#undef GAPM
#undef GAPB
#undef EX_
#undef VRD
#undef KRD
#undef STEP
#undef ENDW
#undef KLOAD2
#undef ROT
#undef MX3
#undef DECIDE
#undef RESC
#undef DMA_K
#undef DMA_V
#undef MK_GROW0
#undef SBAR_
    { const auto rr = __builtin_amdgcn_permlane32_swap(__float_as_uint(l_reg), __float_as_uint(l_reg), false, false); l_reg = __uint_as_float(rr[0]) + __uint_as_float(rr[1]); }
    const float inv = 1.f / l_reg;
    const int le_ = attn_lane_();
    bf16* gp = (bf16*)(p.ws + WS_GATE) + (size_t)((ctxq ? NLAT + b * 256 : b * 2048 + qb * 256) + wid * 32 + (le_ & 31)) * 1024 + h * 64 + 8 * (le_ >> 5);
#pragma unroll
    for (int tl = 0; tl < 2; ++tl)
#pragma unroll
        for (int pr = 0; pr < 2; ++pr) {
            const u32x4 gw = *(const u32x4*)(gp + 32 * tl + 16 * pr);
            float v[8];
#pragma unroll
            for (int e = 0; e < 4; ++e) {
                const float lo = tl ? o1[8 * pr + e] : o0[8 * pr + e], hi_ = tl ? o1[8 * pr + 4 + e] : o0[8 * pr + 4 + e];
                const auto rr = __builtin_amdgcn_permlane32_swap(__float_as_uint(lo), __float_as_uint(hi_), false, false);
                v[e] = __uint_as_float(rr[0]); v[4 + e] = __uint_as_float(rr[1]);
            }
            u32x4 ow;
            ow.x = pk2(v[0] * inv * siluf(lo_bf(gw.x)), v[1] * inv * siluf(hi_bf(gw.x))); ow.y = pk2(v[2] * inv * siluf(lo_bf(gw.y)), v[3] * inv * siluf(hi_bf(gw.y)));
            ow.z = pk2(v[4] * inv * siluf(lo_bf(gw.z)), v[5] * inv * siluf(hi_bf(gw.z))); ow.w = pk2(v[6] * inv * siluf(lo_bf(gw.w)), v[7] * inv * siluf(hi_bf(gw.w)));
            *(u32x4*)(gp + 32 * tl + 16 * pr) = ow;
        }
    asm volatile("s_waitcnt lgkmcnt(0)\n\ts_barrier" ::: "memory");
}
DI void attn_run_unit(const Ptrs& p, int l, LAS unsigned char* lds, int u, int tid) {
    bool mla, ctxq; int b, h, qb;
    if (u < 1536) { const int v = u < 768 ? u : u - 768; mla = u < 768; ctxq = false; b = v / 48; h = (v % 48) / 8; qb = v % 8; }
    else { const int v = u - 1536, w = v % 96; mla = v < 96; ctxq = true; b = w / 6; h = w % 6; qb = 0; }
    if (mla) attn_unit_m(p, l, lds, b, h, qb, ctxq, tid);
    else attn_unit_g(p, l, lds, b, h, qb, ctxq, tid);
}
DI int attn_list_len(int l) { return 192 + (l == 0 ? 24 : 0); }
DI void attn_run_list_unit(const Ptrs& p, int l, LAS unsigned char* lds, int x, int j, int tid) {
    if (j < 192) { const int ty = j / 96, jj = j % 96, pr = x + 8 * (jj >> 3), qb = jj & 7;
        if (ty == 0) attn_unit<true>(p, l, lds, pr / 6, pr % 6, qb, false, tid); else attn_unit<false>(p, l, lds, pr / 6, pr % 6, qb, false, tid); }
    else { const int jj = j - 192, ty = jj / 12, pr = x + 8 * (jj % 12);
        if (ty == 0) attn_unit<true>(p, l, lds, pr / 6, pr % 6, 0, true, tid); else attn_unit<false>(p, l, lds, pr / 6, pr % 6, 0, true, tid); }
}
DI void p4_attention(const Ptrs& p, int l, LAS unsigned char* lds, int wg, int nwg, int tid) {
    const int nunits = 1536 + (l == 0 ? 192 : 0);
    for (int u = wg; u < nunits; u += nwg) {
        if (u < 768) attn_unit<true>(p, l, lds, u / 48, (u % 48) / 8, u % 8, false, tid);
        else if (u < 1536) { const int v = u - 768; attn_unit<false>(p, l, lds, v / 48, (v % 48) / 8, v % 8, false, tid); }
        else { const int v = u - 1536, w = v % 96; if (v < 96) attn_unit<true>(p, l, lds, w / 6, w % 6, 0, true, tid); else attn_unit<false>(p, l, lds, w / 6, w % 6, 0, true, tid); }
    }
}
}
namespace mk {
constexpr size_t GI_ITEM = 67584, GI_QF = 0, GI_KTF = 8192, GI_DIR = 16384, GI_DIRSZ = 25600, GI_WF = 0, GI_AF = 8192, GI_UC = 16384, GI_VEC = 24576;
DI int gdn_row0(int b, int ci) { return ci < 4 ? NLAT + b * 256 + ci * 64 : b * 2048 + (ci - 4) * 64; }
typedef float f32x4v __attribute__((ext_vector_type(4)));
#define MK_MFMA16(a, b, c) __builtin_amdgcn_mfma_f32_16x16x32_bf16((a), (b), (c), 0, 0, 0)

constexpr int PL_KB = 0, PL_KBT = 9216, PL_QB = 18432, PL_VT = 27648, PL_G = 36864, PL_QK = 53504, PL_NS = 70144, PL_TB = 102912, PL_VEC = 139776;

#ifndef MK_TSI
#define MK_TSI(tag) do { } while (0)
#endif
struct PrepPf { u32x4 r[5]; float bb, aa; };
constexpr int PL_WL = 141824;
DI void gdn_prep_item(const Ptrs& p, int l, LAS unsigned char* lds, int b, int ci, int head, int tid, PrepPf& pf, bool first, bool has_next, int nb_, int nci_) {
    asm volatile("" : "+v"(tid));
    const int wave = tid >> 6, lane = tid & 63;
    const int R0 = gdn_row0(b, ci);
    const int t0 = ci < 4 ? ci * 64 : (ci - 4) * 64, slen = ci < 4 ? 256 : 2048;
    unsigned char* gi = p.ws + WS_GDNI + (size_t)((b * 36 + ci) * 4 + head) * GI_ITEM;
    const bf16* GDN = (const bf16*)(p.ws + WS_GDN);
    LAS bf16* Kb = (LAS bf16*)(lds + PL_KB); LAS bf16* KbT = (LAS bf16*)(lds + PL_KBT); LAS bf16* Qb = (LAS bf16*)(lds + PL_QB); LAS bf16* VT = (LAS bf16*)(lds + PL_VT);
    LAS float* Gm = (LAS float*)(lds + PL_G); LAS float* QKm = (LAS float*)(lds + PL_QK);
    MK_TSI(16);
    {
        LAS unsigned char* raw = lds + PL_NS;
        if (first) {
            for (int e = tid; e < 68 * 24; e += NT) {
                const int r = e / 24, q = e % 24, part = q >> 3, ch8 = q & 7, ts = t0 - 2 + r;
                u32x4 v = {0u, 0u, 0u, 0u};
                if (ts >= 0 && ts < slen) v = *(const u32x4*)(GDN + (size_t)(R0 - 2 + r) * 768 + part * 256 + head * 64 + ch8 * 8);
                *(LAS u32x4*)(raw + r * 400 + part * 128 + ch8 * 16) = v;
            }
            LAS float* wl = (LAS float*)(lds + PL_WL);
            for (int e = tid; e < 960; e += NT) { const int part = e / 320, j = (e % 320) >> 6, cc = e & 63; wl[e] = p.gdn_conv_w[(size_t)l * 5 * 768 + j * 768 + part * 256 + head * 64 + cc]; }
        } else if (wave >= 2) {
#pragma unroll
            for (int k = 0; k < 5; ++k) { const int e = tid - 128 + 384 * k; if (e < 68 * 24) { const int r = e / 24, q = e % 24; *(LAS u32x4*)(raw + r * 400 + (q >> 3) * 128 + (q & 7) * 16) = pf.r[k]; } }
        }
    }
    __syncthreads();
    MK_TSI(17);
    {
        const int t = tid >> 3, c8 = tid & 7;
        const LAS unsigned char* raw = lds + PL_NS + t * 400 + c8 * 16;
        const LAS float* wl = (const LAS float*)(lds + PL_WL) + c8 * 8;
#pragma unroll
        for (int part = 0; part < 3; ++part) {
            float acc[8];
#pragma unroll
            for (int i = 0; i < 8; ++i) acc[i] = 0.f;
#pragma unroll
            for (int j = 0; j < 5; ++j) {
                const u32x4 x = *(const LAS u32x4*)(raw + j * 400 + part * 128);
                const f32x4v w0 = *(const LAS f32x4v*)(wl + part * 320 + j * 64), w1 = *(const LAS f32x4v*)(wl + part * 320 + j * 64 + 4);
                acc[0] += lo_bf(x.x) * w0.x; acc[1] += hi_bf(x.x) * w0.y; acc[2] += lo_bf(x.y) * w0.z; acc[3] += hi_bf(x.y) * w0.w;
                acc[4] += lo_bf(x.z) * w1.x; acc[5] += hi_bf(x.z) * w1.y; acc[6] += lo_bf(x.w) * w1.z; acc[7] += hi_bf(x.w) * w1.w;
            }
            float ss = 0.f;
#pragma unroll
            for (int i = 0; i < 8; ++i) { acc[i] = acc[i] / (1.f + __expf(-acc[i])); ss += acc[i] * acc[i]; }
            if (part < 2) {
                ss += __builtin_bit_cast(float, __builtin_amdgcn_update_dpp(0, __builtin_bit_cast(int, ss), 0xB1, 0xF, 0xF, false));
                ss += __builtin_bit_cast(float, __builtin_amdgcn_update_dpp(0, __builtin_bit_cast(int, ss), 0x4E, 0xF, 0xF, false));
                ss += __builtin_bit_cast(float, __builtin_amdgcn_update_dpp(0, __builtin_bit_cast(int, ss), 0x141, 0xF, 0xF, false));
                const float rn = (part == 0 ? 0.125f : 1.f) / sqrtf(ss + EPS);
#pragma unroll
                for (int i = 0; i < 8; ++i) acc[i] *= rn;
            }
            u32x4 w; w.x = pk2(acc[0], acc[1]); w.y = pk2(acc[2], acc[3]); w.z = pk2(acc[4], acc[5]); w.w = pk2(acc[6], acc[7]);
            if (part == 0) *(LAS u32x4*)(Qb + t * 72 + c8 * 8) = w;
            else {
                if (part == 1) *(LAS u32x4*)(Kb + t * 72 + c8 * 8) = w;
                LAS bf16* tp = (part == 1 ? KbT : VT) + (c8 * 8) * 72 + t;
                tp[0 * 72] = (bf16)(w.x & 0xffffu); tp[1 * 72] = (bf16)(w.x >> 16); tp[2 * 72] = (bf16)(w.y & 0xffffu); tp[3 * 72] = (bf16)(w.y >> 16);
                tp[4 * 72] = (bf16)(w.z & 0xffffu); tp[5 * 72] = (bf16)(w.z >> 16); tp[6 * 72] = (bf16)(w.w & 0xffffu); tp[7 * 72] = (bf16)(w.w >> 16);
            }
        }
    }
    MK_TSI(18);
    if (wave >= 6) {
        const int d = wave - 6;
        const float* ba = (const float*)(p.ws + WS_BA) + (size_t)(R0 + lane) * 16;
        const float bbv = first ? ba[d * 4 + head] : pf.bb, aav = first ? ba[8 + d * 4 + head] : pf.aa;
        const float beta = 1.f / (1.f + __expf(-bbv));
        const float xa = aav + p.gdn_dt_bias[l * 8 + d * 4 + head];
        const float ex = __expf(xa);
        const float sp = xa > 20.f ? xa : (ex < 0.03f ? ex * (1.f - ex * (0.5f - ex * 0.33333334f)) : __logf(1.f + ex));
        const float g = -__expf(p.gdn_a_log[l * 8 + d * 4 + head]) * sp;
        float c = g;
#pragma unroll
        for (int o = 1; o < 64; o <<= 1) { const float nb = shl_(c, d == 0 ? (lane - o) & 63 : (lane + o) & 63, lane); const bool ok = d == 0 ? (lane >= o) : (lane + o < 64); c += ok ? nb : 0.f; }
        const float clast = shl_(c, d == 0 ? 63 : 0, lane);
        LAS float* vec = (LAS float*)(lds + PL_VEC + d * 1024);
        vec[lane] = c; vec[64 + lane] = beta; vec[128 + lane] = __expf(c); vec[192 + lane] = __expf(clast - c);
        float* gv = (float*)(gi + GI_DIR + d * GI_DIRSZ + GI_VEC);
        gv[lane] = __expf(c); gv[64 + lane] = __expf(clast - c); if (lane == 0) gv[128] = __expf(clast);
    }
    __syncthreads();
    MK_TSI(19);
    {
        const int prod = wave >> 2, tt = (wave >> 1) & 1, st = wave & 1, r32 = lane & 31, hh = lane >> 5;
        const LAS bf16* Am = prod == 0 ? Kb : Qb;
        f32x16 acc = {};
#pragma unroll
        for (int s = 0; s < 4; ++s) {
            const bf16x8 a = *(const LAS bf16x8*)(Am + (32 * tt + r32) * 72 + 16 * s + 8 * hh);
            const bf16x8 bb = *(const LAS bf16x8*)(Kb + (32 * st + r32) * 72 + 16 * s + 8 * hh);
            acc = MK_MFMA32(a, bb, acc);
        }
        LAS float* Om = prod == 0 ? Gm : QKm;
#pragma unroll
        for (int r = 0; r < 16; ++r) Om[(32 * tt + (r & 3) + 8 * (r >> 2) + 4 * hh) * 65 + 32 * st + r32] = acc[r];
    }
    __syncthreads();
    MK_TSI(20);
    {
        const int d = tid >> 8, lt = tid & 255;
        const LAS float* vec = (const LAS float*)(lds + PL_VEC + d * 1024);
        LAS float* Ns = (LAS float*)(lds + PL_NS + d * 16384);
        for (int e = lt; e < 4096; e += 256) {
            const int i2 = e >> 6, i = e & 63, t = d ? 63 - i : i, t2 = d ? 63 - i2 : i2;
            Ns[i2 * 64 + i] = i2 < i ? vec[64 + t] * Gm[t * 65 + t2] * __expf(vec[t] - vec[t2]) : 0.f;
        }
    }
    __syncthreads();
    MK_TSI(21);
    if (wave < 2) {
        const int d = wave;
        const LAS float* Ns = (const LAS float*)(lds + PL_NS + d * 16384);
        const LAS float* vec = (const LAS float*)(lds + PL_VEC + d * 1024);
        f32x2 Tp[32];
#pragma unroll
        for (int i = 0; i < 32; ++i) Tp[i] = (f32x2){(2 * i == lane) ? 1.f : 0.f, (2 * i + 1 == lane) ? 1.f : 0.f};
        f32x4v nva[16], nvb[16];
#pragma unroll
        for (int i4 = 0; i4 < 16; ++i4) nva[i4] = *(const LAS f32x4v*)(Ns + 4 * i4);
#define MK_SOLVE_STEP(j, CUR, NXT) do { \
            if ((j) + 1 < 63) { _Pragma("unroll") for (int i4 = ((j) + 2) / 4; i4 < 16; ++i4) NXT[i4] = *(const LAS f32x4v*)(Ns + ((j) + 1) * 64 + 4 * i4); } \
            const float tj = ((j) & 1) ? Tp[(j) >> 1].y : Tp[(j) >> 1].x; const f32x2 tj2 = {tj, tj}; \
            _Pragma("unroll") for (int i4 = ((j) + 1) / 4; i4 < 16; ++i4) { \
                Tp[2 * i4] -= (f32x2){CUR[i4].x, CUR[i4].y} * tj2; Tp[2 * i4 + 1] -= (f32x2){CUR[i4].z, CUR[i4].w} * tj2; } \
            __builtin_amdgcn_sched_barrier(0); } while (0)
#pragma unroll
        for (int j = 0; j < 62; j += 2) { MK_SOLVE_STEP(j, nva, nvb); MK_SOLVE_STEP(j + 1, nvb, nva); }
        MK_SOLVE_STEP(62, nva, nvb);
#undef MK_SOLVE_STEP
        const int sc = d ? 63 - lane : lane;
        const float bs = vec[64 + sc], bc = bs * vec[128 + sc];
        LAS bf16* Tb = (LAS bf16*)(lds + PL_TB + d * 18432); LAS bf16* Tc = Tb + 4608;
#pragma unroll
        for (int i = 0; i < 64; ++i) { const int t = d ? 63 - i : i; const float ti = (i & 1) ? Tp[i >> 1].y : Tp[i >> 1].x; Tb[t * 72 + sc] = (bf16)f2bf(ti * bs); Tc[t * 72 + sc] = (bf16)f2bf(ti * bc); }
    } else {
        const int ew = wave - 2;
        for (int e = ew * 64 + lane; e < 1024; e += 384) {
            const int which = e >> 9, f = (e >> 6) & 7, ln = e & 63, mt = f >> 1, ks = f & 1, r = ln & 15, g = ln >> 4;
            const LAS bf16* src = (which == 0 ? Qb : KbT) + (16 * mt + r) * 72 + 32 * ks + 4 * g;
            const u32x2 lo = *(const LAS u32x2*)src, hi = *(const LAS u32x2*)(src + 16);
            *(u32x4*)(gi + (which == 0 ? GI_QF : GI_KTF) + (size_t)f * 1024 + ln * 16) = (u32x4){lo.x, lo.y, hi.x, hi.y};
        }
        for (int e = ew * 64 + lane; e < 1024; e += 384) {
            const int d = e >> 9, f = (e >> 6) & 7, ln = e & 63, mt = f >> 1, ks = f & 1, r = ln & 15, g = ln >> 4, t = 16 * mt + r;
            const LAS float* vec = (const LAS float*)(lds + PL_VEC + d * 1024);
            const float ct = vec[t];
            float v[8];
#pragma unroll
            for (int j = 0; j < 8; ++j) { const int s = 32 * ks + (j < 4 ? 4 * g + j : 16 + 4 * g + (j - 4)); const bool ok = d ? (s >= t) : (s <= t); v[j] = ok ? QKm[t * 65 + s] * __expf(ct - vec[s]) : 0.f; }
            u32x4 w; w.x = pk2(v[0], v[1]); w.y = pk2(v[2], v[3]); w.z = pk2(v[4], v[5]); w.w = pk2(v[6], v[7]);
            *(u32x4*)(gi + GI_DIR + d * GI_DIRSZ + GI_AF + (size_t)f * 1024 + ln * 16) = w;
        }
        if (has_next) {
            const int nR0 = gdn_row0(nb_, nci_), nt0 = nci_ < 4 ? nci_ * 64 : (nci_ - 4) * 64, nslen = nci_ < 4 ? 256 : 2048;
#pragma unroll
            for (int k = 0; k < 5; ++k) { const int e = tid - 128 + 384 * k; u32x4 v = {0u, 0u, 0u, 0u};
                if (e < 68 * 24) { const int r = e / 24, q = e % 24, ts = nt0 - 2 + r; if (ts >= 0 && ts < nslen) v = *(const u32x4*)(GDN + (size_t)(nR0 - 2 + r) * 768 + (q >> 3) * 256 + head * 64 + (q & 7) * 8); }
                pf.r[k] = v; }
            if (wave >= 6) { const int d = wave - 6; const float* nba = (const float*)(p.ws + WS_BA) + (size_t)(nR0 + lane) * 16; pf.bb = nba[d * 4 + head]; pf.aa = nba[8 + d * 4 + head]; }
        }
    }
    __syncthreads();
    MK_TSI(22);
    {
        const int d = wave >> 2, r32 = lane & 31, hh = lane >> 5;
        const LAS bf16* Tb = (const LAS bf16*)(lds + PL_TB + d * 18432); const LAS bf16* Tc = Tb + 4608;
        LAS bf16* uT = (LAS bf16*)(lds + PL_G + d * 16640); LAS bf16* Wb = (LAS bf16*)(lds + PL_NS + d * 16384);
#pragma unroll
        for (int q = 0; q < 2; ++q) {
            const int task = (wave & 3) * 2 + q, isw = task >> 2, ta = (task >> 1) & 1, tb2 = task & 1;
            const LAS bf16* Ap = (isw ? KbT : Tb) + (32 * ta + r32) * 72 + 8 * hh;
            const LAS bf16* Bp = (isw ? Tc : VT) + (32 * tb2 + r32) * 72 + 8 * hh;
            f32x16 acc = {};
#pragma unroll
            for (int s = 0; s < 4; ++s) acc = MK_MFMA32(*(const LAS bf16x8*)(Ap + 16 * s), *(const LAS bf16x8*)(Bp + 16 * s), acc);
            LAS bf16* Op = (isw ? Wb : uT) + (32 * tb2 + r32) * 72 + 32 * ta + 4 * hh;
#pragma unroll
            for (int g4 = 0; g4 < 4; ++g4) { u32x2 w; w.x = pk2(acc[4 * g4], acc[4 * g4 + 1]); w.y = pk2(acc[4 * g4 + 2], acc[4 * g4 + 3]); *(LAS u32x2*)(Op + 8 * g4) = w; }
        }
    }
    __syncthreads();
    MK_TSI(23);
    {
        const int d = tid >> 8, lt = tid & 255;
        const LAS bf16* uT = (const LAS bf16*)(lds + PL_G + d * 16640); const LAS bf16* Wb = (const LAS bf16*)(lds + PL_NS + d * 16384);
        unsigned char* gd = gi + GI_DIR + d * GI_DIRSZ;
        for (int e = lt; e < 512; e += 256) {
            const int f = e >> 6, ln = e & 63, mt = f >> 1, ks = f & 1, r = ln & 15, g = ln >> 4;
            const LAS bf16* src = Wb + (16 * mt + r) * 72 + 32 * ks + 4 * g;
            const u32x2 lo = *(const LAS u32x2*)src, hi = *(const LAS u32x2*)(src + 16);
            *(u32x4*)(gd + GI_WF + (size_t)f * 1024 + ln * 16) = (u32x4){lo.x, lo.y, hi.x, hi.y};
        }
        for (int e = lt; e < 1024; e += 256) {
            const int f = e >> 6, ln = e & 63, wv = f >> 2, mt = f & 3, c = ln & 15, g = ln >> 4;
            *(u32x2*)(gd + GI_UC + (size_t)f * 512 + ln * 8) = *(const LAS u32x2*)(uT + (16 * wv + c) * 72 + 16 * mt + 4 * g);
        }
    }
    __syncthreads();
    MK_TSI(24);
}

constexpr int SC_QF = 0, SC_KTF = 8192, SC_WF = 16384, SC_AF = 24576, SC_UC = 32768, SC_VEC = 40960, SC_BUF = 41984;
DI int scan_ci(int step, int d) { return step < 4 ? (d ? 3 - step : step) : 4 + (d ? 35 - step : step - 4); }
DI void gdn_scan_chain(const Ptrs& p, LAS unsigned char* lds, size_t of_off, size_t ob_off, int b, int head, int d, int tid) {
    asm volatile("" : "+v"(tid));
    const int wave = __builtin_amdgcn_readfirstlane(tid >> 6), lane = tid & 63;
    const unsigned char* gbase = p.ws + WS_GDNI + (size_t)(b * 36 * 4 + head) * GI_ITEM;
    __syncthreads();
    if (wave >= 4) {
        const int lw = wave - 4;
#define MK_SC_ISSUE(step) do { const int _ci = scan_ci((step), d); const unsigned char* _gi = gbase + (size_t)_ci * 4 * GI_ITEM; const unsigned char* _gd = _gi + GI_DIR + d * GI_DIRSZ; \
        LAS unsigned char* _buf = lds + ((step) % 3) * SC_BUF; \
        _Pragma("unroll") for (int _k = 0; _k < 11; ++_k) { int _p = lw + 4 * _k; if (_p > 40) _p = lw; \
            const unsigned char* _src = (_p < 16 ? _gi + (size_t)_p * 1024 : _gd + (size_t)(_p - 16) * 1024) + lane * 16; \
            __builtin_amdgcn_global_load_lds((const unsigned*)_src, (LAS unsigned*)(_buf + _p * 1024), 16, 0, 0); } } while (0)
        MK_SC_ISSUE(0); MK_SC_ISSUE(1);
        for (int s = 0; s < 36; ++s) {
            if (s + 1 < 36) asm volatile("s_waitcnt vmcnt(11)" ::: "memory"); else asm volatile("s_waitcnt vmcnt(0)" ::: "memory");
            asm volatile("" ::: "memory"); __builtin_amdgcn_s_barrier(); asm volatile("" ::: "memory");
            if (s + 2 < 36) MK_SC_ISSUE(s + 2);
        }
#undef MK_SC_ISSUE
    } else {
        const int wv = wave, c = lane & 15, g = lane >> 4;
        bf16* O = (bf16*)(p.ws + (d ? ob_off : of_off));
        f32x4v S[4];
#pragma unroll
        for (int i = 0; i < 4; ++i) S[i] = (f32x4v){0.f, 0.f, 0.f, 0.f};
        for (int step = 0; step < 36; ++step) {
            asm volatile("" ::: "memory"); __builtin_amdgcn_s_barrier(); asm volatile("" ::: "memory");
            __builtin_amdgcn_sched_barrier(0);
            const LAS unsigned char* buf = lds + (step % 3) * SC_BUF;
            const LAS float* vec = (const LAS float*)(buf + SC_VEC);
            const float gl = vec[128];
            bf16x8 Sb[2];
#pragma unroll
            for (int ks = 0; ks < 2; ++ks) { u32x4 w; w.x = pk2(S[2 * ks][0], S[2 * ks][1]); w.y = pk2(S[2 * ks][2], S[2 * ks][3]); w.z = pk2(S[2 * ks + 1][0], S[2 * ks + 1][1]); w.w = pk2(S[2 * ks + 1][2], S[2 * ks + 1][3]); Sb[ks] = __builtin_bit_cast(bf16x8, w); }
            f32x4v vn[4], o[4];
            const LAS bf16x8* wF = (const LAS bf16x8*)(buf + SC_WF) + lane; const LAS bf16x8* qF = (const LAS bf16x8*)(buf + SC_QF) + lane;
            const LAS bf16x8* aF = (const LAS bf16x8*)(buf + SC_AF) + lane; const LAS bf16x8* kF = (const LAS bf16x8*)(buf + SC_KTF) + lane;
#pragma unroll
            for (int mt = 0; mt < 4; ++mt) {
                f32x4v ws = {0.f, 0.f, 0.f, 0.f}, qs = {0.f, 0.f, 0.f, 0.f};
#pragma unroll
                for (int ks = 0; ks < 2; ++ks) { ws = MK_MFMA16(wF[(2 * mt + ks) * 64], Sb[ks], ws); qs = MK_MFMA16(qF[(2 * mt + ks) * 64], Sb[ks], qs); }
                const u32x2 uu = *(const LAS u32x2*)(buf + SC_UC + (wv * 4 + mt) * 512 + lane * 8);
                const f32x4v ec = *(const LAS f32x4v*)(vec + 16 * mt + 4 * g);
                vn[mt] = (f32x4v){lo_bf(uu.x) - ws[0], hi_bf(uu.x) - ws[1], lo_bf(uu.y) - ws[2], hi_bf(uu.y) - ws[3]};
                o[mt] = ec * qs;
            }
            bf16x8 Vb[2], Vb2[2];
#pragma unroll
            for (int ks = 0; ks < 2; ++ks) {
                const f32x4v e0 = *(const LAS f32x4v*)(vec + 64 + 16 * (2 * ks) + 4 * g), e1 = *(const LAS f32x4v*)(vec + 64 + 16 * (2 * ks + 1) + 4 * g);
                const f32x4v a0 = vn[2 * ks], a1 = vn[2 * ks + 1], b0 = a0 * e0, b1 = a1 * e1;
                u32x4 w; w.x = pk2(a0[0], a0[1]); w.y = pk2(a0[2], a0[3]); w.z = pk2(a1[0], a1[1]); w.w = pk2(a1[2], a1[3]); Vb[ks] = __builtin_bit_cast(bf16x8, w);
                u32x4 w2; w2.x = pk2(b0[0], b0[1]); w2.y = pk2(b0[2], b0[3]); w2.z = pk2(b1[0], b1[1]); w2.w = pk2(b1[2], b1[3]); Vb2[ks] = __builtin_bit_cast(bf16x8, w2);
            }
            const int R0 = gdn_row0(b, scan_ci(step, d));
#pragma unroll
            for (int mt = 0; mt < 4; ++mt) {
                f32x4v oo = o[mt];
#pragma unroll
                for (int ks = 0; ks < 2; ++ks) oo = MK_MFMA16(aF[(2 * mt + ks) * 64], Vb[ks], oo);
                bf16* op = O + (size_t)(R0 + 16 * mt + 4 * g) * 256 + head * 64 + 16 * wv + c;
#pragma unroll
                for (int i = 0; i < 4; ++i) op[(size_t)i * 256] = (bf16)f2bf(oo[i]);
            }
#pragma unroll
            for (int dt = 0; dt < 4; ++dt) {
                f32x4v sn = S[dt] * gl;
#pragma unroll
                for (int ks = 0; ks < 2; ++ks) sn = MK_MFMA16(kF[(2 * dt + ks) * 64], Vb2[ks], sn);
                S[dt] = sn;
            }
            asm volatile("s_waitcnt lgkmcnt(0)" ::: "memory");
        }
    }
    __syncthreads();
}
DI void p3_gdnprep(const Ptrs& p, int l, LAS unsigned char* lds, int wg, int nwg, int tid, int nb) {
    PrepPf pf;
#pragma unroll
    for (int k = 0; k < 5; ++k) pf.r[k] = (u32x4){0u, 0u, 0u, 0u};
    pf.bb = 0.f; pf.aa = 0.f;
    const bool samehead = (nwg & 3) == 0;
    bool first = true;
    for (int it = wg; it < nb * 144; it += nwg) {
        const int nx = it + nwg; const bool has_next = samehead && nx < nb * 144;
        gdn_prep_item(p, l, lds, it / 144, (it % 144) >> 2, it & 3, tid, pf, first, has_next, nx / 144, (nx % 144) >> 2);
        first = !samehead;
    }
}
DI void p4_gdnscan(const Ptrs& p, LAS unsigned char* lds, size_t of_off, size_t ob_off, int wg, int nwg, int tid, int nb) {
    for (int ch = wg; ch < nb * 8; ch += nwg) gdn_scan_chain(p, lds, of_off, ob_off, ch >> 3, (ch >> 1) & 3, ch & 1, tid);
}
}
namespace mk {
DI void p5_gdn_combine(const Ptrs& p, int l, int nrows, int gw, int ngw, int lane) {
    const bf16* OF = (const bf16*)(p.ws + WS_CQ); const bf16* OB = (const bf16*)(p.ws + WS_CKV); bf16* G = (bf16*)(p.ws + WS_GATE);
    const f32x4 og = *(const f32x4*)(p.gdn_on_g + l * 64 + (lane & 15) * 4);
    for (int Rb = gw; Rb < nrows; Rb += 4 * ngw) {
        u32x2 a4[4], b4[4], g4[4];
#pragma unroll
        for (int k = 0; k < 4; ++k) { const int R = Rb + k * ngw < nrows ? Rb + k * ngw : Rb;
            a4[k] = *(const u32x2*)(OF + (size_t)R * 256 + lane * 4); b4[k] = *(const u32x2*)(OB + (size_t)R * 256 + lane * 4); g4[k] = *(const u32x2*)(G + (size_t)R * 1024 + 768 + lane * 4); }
#pragma unroll
        for (int k = 0; k < 4; ++k) {
            const int R = Rb + k * ngw;
            if (R >= nrows) break;
            const u32x2 a = a4[k], bq = b4[k];
            const float o0 = lo_bf(a.x) + lo_bf(bq.x), o1 = hi_bf(a.x) + hi_bf(bq.x), o2 = lo_bf(a.y) + lo_bf(bq.y), o3 = hi_bf(a.y) + hi_bf(bq.y);
            float ss = o0 * o0 + o1 * o1 + o2 * o2 + o3 * o3;
            ss += shx(ss, 1, lane); ss += shx(ss, 2, lane); ss += shx(ss, 4, lane); ss += shx(ss, 8, lane);
            const float rstd = 1.f / sqrtf(ss * (1.f / 64.f) + EPS);
            bf16* gp = G + (size_t)R * 1024 + 768 + lane * 4;
            u32x2 gw2 = g4[k];
            gw2.x = pk2(o0 * rstd * og.x * siluf(lo_bf(gw2.x)), o1 * rstd * og.y * siluf(hi_bf(gw2.x)));
            gw2.y = pk2(o2 * rstd * og.z * siluf(lo_bf(gw2.y)), o3 * rstd * og.w * siluf(hi_bf(gw2.y)));
            *(u32x2*)gp = gw2;
        }
    }
}
struct EpiY {
    static constexpr bool PERM = true, AFTER_DRAIN = false;
    bf16* Y; const float* mod_l;
    DI void operator()(const pg8::f32x4 (&acc)[2][2][4][2], const pg8::Unit& u, int wr, int wc, int fr, int fq) const {
        const int row0 = u.pm * 256 + wr * 64 + fr;
        const float* gt = mod_l + (size_t)(u.pm >= NLAT / 256 ? 16 : (u.pm >> 3)) * 3072 + 2048;
#pragma unroll
        for (int bj = 0; bj < 2; ++bj) {
            const int c = 256 * u.pn + 128 * bj + 32 * wc + 8 * fq;
            const pg8::f32x4 g0 = *(const pg8::f32x4*)(gt + c), g1 = *(const pg8::f32x4*)(gt + c + 4);
#pragma unroll
            for (int ai = 0; ai < 2; ++ai)
#pragma unroll
                for (int m = 0; m < 4; ++m) { const int row = row0 + ai * 128 + m * 16;
                    const pg8::f32x4 v0 = acc[ai][bj][m][0] * g0, v1 = acc[ai][bj][m][1] * g1;
                    u32x4 w; w.x = pk2(v0[0], v0[1]); w.y = pk2(v0[2], v0[3]); w.z = pk2(v1[0], v1[1]); w.w = pk2(v1[2], v1[3]);
                    *(u32x4*)(Y + (size_t)row * 1024 + c) = w; }
        }
    }
};
DI void p7_final(const Ptrs& p, int gw, int ngw, int lane) {
    const bf16* Y = (const bf16*)(p.ws + WS_H);
    const int rpw = (NLAT + ngw - 1) / ngw, rbeg = gw * rpw, rend = rbeg + rpw < NLAT ? rbeg + rpw : NLAT;
    f32x4 g[4];
#pragma unroll
    for (int j = 0; j < 4; ++j) g[j] = *(const f32x4*)(p.final_g + lane * 4 + 256 * j);
    f32x4 v0[4], v1[4]; u32x2 y0[4], y1[4];
#define MK_P7_LOAD(R_, A0, A1, Y0, Y1) do { const int _R = (R_), _R1 = _R + 1 < rend ? _R + 1 : _R; \
        _Pragma("unroll") for (int j = 0; j < 4; ++j) { A0[j] = *(const f32x4*)(p.out + (size_t)_R * 1024 + lane * 4 + 256 * j); A1[j] = *(const f32x4*)(p.out + (size_t)_R1 * 1024 + lane * 4 + 256 * j); \
            Y0[j] = *(const u32x2*)(Y + (size_t)_R * 1024 + lane * 4 + 256 * j); Y1[j] = *(const u32x2*)(Y + (size_t)_R1 * 1024 + lane * 4 + 256 * j); } } while (0)
    if (rbeg < rend) MK_P7_LOAD(rbeg, v0, v1, y0, y1);
    for (int R = rbeg; R < rend; R += 2) {
        const bool two = R + 1 < rend; const int R1 = two ? R + 1 : R;
        const bool more = R + 2 < rend;
        f32x4 n0[4], n1[4]; u32x2 ny0[4], ny1[4];
        if (more) MK_P7_LOAD(R + 2, n0, n1, ny0, ny1);
#pragma unroll
        for (int rr = 0; rr < 2; ++rr) {
            if (rr == 1 && !two) break;
            float ss = 0.f; f32x4 x[4];
#pragma unroll
            for (int j = 0; j < 4; ++j) { const f32x4 v = rr ? v1[j] : v0[j]; const u32x2 y = rr ? y1[j] : y0[j];
                x[j] = (f32x4){v.x + __builtin_bit_cast(float, y.x << 16), v.y + __builtin_bit_cast(float, y.x & 0xffff0000u), v.z + __builtin_bit_cast(float, y.y << 16), v.w + __builtin_bit_cast(float, y.y & 0xffff0000u)};
                ss += (x[j].x * x[j].x + x[j].y * x[j].y) + (x[j].z * x[j].z + x[j].w * x[j].w); }
            ss = wave_sum(ss, lane);
            const float rstd = 1.f / sqrtf(ss * (1.f / 1024.f) + EPS);
            float* xr = p.out + (size_t)(rr ? R1 : R) * 1024;
#pragma unroll
            for (int j = 0; j < 4; ++j) *(f32x4*)(xr + lane * 4 + 256 * j) = (f32x4){x[j].x * rstd * g[j].x, x[j].y * rstd * g[j].y, x[j].z * rstd * g[j].z, x[j].w * rstd * g[j].w};
        }
        if (more) {
#pragma unroll
            for (int j = 0; j < 4; ++j) { v0[j] = n0[j]; v1[j] = n1[j]; y0[j] = ny0[j]; y1[j] = ny1[j]; }
        }
    }
#undef MK_P7_LOAD
}
}
#ifndef MK_PG8_ALIGN
#define MK_PG8_ALIGN true
#endif
#ifndef MK_PG8_SP2
#define MK_PG8_SP2 true
#endif
namespace mk {
struct InOrderL1 {
    pg8::StaticOrder lat; int G, c;
    DI bool next(int i, pg8::Unit& u) const {
        const int nlat = (NLAT / 256) * (NIN_PAD / 256);
        const long L = (long)i * G + c;
        if (L < nlat) return lat.next(i, u);
        const int idx = (int)(L - nlat); if (idx >= (NCTX / 256) * 7) return false;
        const int k = idx % 7; u.pm = NLAT / 256 + idx / 7; u.pn = k == 0 ? 1 : (k == 1 ? 2 : (k == 6 ? 12 : k + 2)); return true;
    }
    DI void a_ready(const pg8::Unit&) const {}
    DI void done(const pg8::Unit&) const {}
};
DI int mk_lane_volatile() { int ln; asm volatile("v_mbcnt_lo_u32_b32 %0, -1, 0\n\tv_mbcnt_hi_u32_b32 %0, -1, %0" : "=v"(ln)); return ln; }
struct KArgs { Ptrs p; int ph_lo, ph_hi; };
constexpr int PH_FINAL = 11, N_PHASES = 12;
#ifndef MK_COOP
#define MK_COOP 0
#endif
__global__ void __launch_bounds__(NT, 2) mega(KArgs a) {
    extern __shared__ __attribute__((aligned(16))) unsigned char lds_raw[];
    LAS unsigned char* lds = (LAS unsigned char*)lds_raw;
    volatile LAS unsigned* misc = (volatile LAS unsigned*)(lds + LDS_BYTES - 256);
    const int wave_s = __builtin_amdgcn_readfirstlane((int)threadIdx.x >> 6);
#define MK_TID() (wave_s * 64 + mk_lane_volatile())
    if (MK_TID() < 64) misc[MK_TID()] = 0u;
    __syncthreads();
    unsigned* ctl = (unsigned*)(a.p.ws + WS_CTL);
    XcdBarrier bar = xcd_barrier_post(ctl + 8192, misc + 8, MK_TID());
    const int G = gridDim.x, wg = blockIdx.x;
#ifdef MK_TSEL
    volatile LAS unsigned* tsb = (volatile LAS unsigned*)(lds + LDS_BYTES - 1280);
    if (MK_TID() == 0) tsb[0] = 0u;
#define MK_TS(tag) do { if (blockIdx.x == 0 && tid == 0) { const unsigned long long _t = __builtin_amdgcn_s_memrealtime(); const unsigned _n = tsb[0]; if (_n < 60) { tsb[1 + 3 * _n] = (tag); tsb[2 + 3 * _n] = (unsigned)_t; tsb[3 + 3 * _n] = (unsigned)(_t >> 32); tsb[0] = _n + 1; } } } while (0)
#else
#define MK_TS(tag) do { } while (0)
#endif
    for (int ph = a.ph_lo; ph < a.ph_hi; ++ph) {
        Ptrs p = a.p;
        const int ngw = G * NWAVES;
#define tid MK_TID()
#define wave (MK_TID() >> 6)
#define lane (MK_TID() & 63)
#define gw (wg * NWAVES + (MK_TID() >> 6))
        const int l = ph >= 6 ? 1 : 0; int sub = ph == 0 ? 0 : (ph == PH_FINAL ? 7 : ph - 5 * l); if (sub == 5) sub = 6;
        if (sub == 0) {
            MK_TS(0);
            p0_mod(p, (LAS float*)lds, wg, G, tid);
            p0_rope(p, wg * NT + tid, G * NT);
        } else if (sub == 1) {
            MK_TS(1);
            p1_norm(p, l, p.x, p.ctx, l == 1, gw, ngw, lane);
            if (l == 0) p0_weights(p, (LAS float*)lds + wave * (64 * 33), gw, ngw, lane);
        } else if (sub == 2) {
            MK_TS(2);
            pg8::Gemm g{(const pg8::bf16_t*)(p.ws + WS_H), (const pg8::bf16_t*)(p.ws + WS_WIN) + (size_t)l * NIN_PAD * 1024, M, NIN_PAD, 1024};
            EpiSeg E{p.ws, (float*)(p.ws + CTL_SSQ) + (size_t)l * 2 * M};
            if (l == 0) {
                pg8::StaticOrder S; S.init(M, NIN_PAD, G, wg);
                pg8::gemm_phase<EpiSeg, pg8::StaticOrder, false, MK_PG8_ALIGN, MK_PG8_SP2>(lds, g, S, E, nullptr, tid);
            } else {
                InOrderL1 S; S.lat.init(NLAT, NIN_PAD, G, wg); S.G = G; S.c = wg;
                pg8::gemm_phase<EpiSeg, InOrderL1, false, MK_PG8_ALIGN, MK_PG8_SP2>(lds, g, S, E, nullptr, tid);
            }
        } else if (sub == 3) {
            MK_TS(3);
            {
                const int Mq = l == 0 ? M : NLAT;
                pg8::Gemm g{(const pg8::bf16_t*)(p.ws + WS_CQ), (const pg8::bf16_t*)(p.ws + WS_WUQ) + (size_t)l * 768 * 384, Mq, 768, 384};
                pg8::StaticOrder S; S.init(Mq, 768, G, wg);
                EpiQup E{(bf16*)(p.ws + WS_QMLA)};
                pg8::gemm_phase<EpiQup, pg8::StaticOrder, false, MK_PG8_ALIGN, MK_PG8_SP2>(lds, g, S, E, nullptr, tid);
            }
            MK_TS(4);
            {
                pg8::Gemm g{(const pg8::bf16_t*)(p.ws + WS_CKV), (const pg8::bf16_t*)(p.ws + WS_WUKV) + (size_t)l * 768 * 256, M, 768, 256};
                pg8::StaticOrder S; S.init(M, 768, G, wg);
                EpiKVup E{(bf16*)(p.ws + WS_KVMLA), (const float*)(p.ws + CTL_SSQ) + (size_t)l * 2 * M + M};
                pg8::gemm_phase<EpiKVup, pg8::StaticOrder, false, MK_PG8_ALIGN, MK_PG8_SP2>(lds, g, S, E, nullptr, tid);
            }
            MK_TS(5);
            p3_qknorm(p, l, gw, ngw, lane);
            MK_TS(6);
            __syncthreads();
            p3_gdnprep(p, l, lds, wg, G, tid, NB);
            MK_TS(7);
        } else if (sub == 4) {
            MK_TS(8);
            p4_gdnscan(p, lds, WS_CQ, WS_CKV, wg, G, tid, NB);
            {
                unsigned* done = ctl + 4224 + 64 * l;
                int nch = 0; for (int ch = wg; ch < NB * 8; ch += G) ++nch;
                if (nch) {
                    asm volatile("s_waitcnt vmcnt(0)" ::: "memory");
                    __syncthreads();
                    if (tid == 0) { __builtin_amdgcn_fence(__ATOMIC_RELEASE, "agent"); asm volatile("s_waitcnt vmcnt(0)" ::: "memory"); __hip_atomic_fetch_add(done, (unsigned)nch, __ATOMIC_RELAXED, __HIP_MEMORY_SCOPE_AGENT); }
                }
            }
            MK_TS(9);
            {
                unsigned* ctr = ctl + 4096 + 64 * l;
                const int nunits = 1536 + (l == 0 ? 192 : 0);
                __syncthreads();
                if (tid == 0) misc[16] = __hip_atomic_fetch_add(ctr, 1u, __ATOMIC_RELAXED, __HIP_MEMORY_SCOPE_AGENT);
                __syncthreads();
                int u = (int)misc[16];
                while (u < nunits) {
                    unsigned nxt = 0u;
                    if (tid == 0) nxt = __hip_atomic_fetch_add(ctr, 1u, __ATOMIC_RELAXED, __HIP_MEMORY_SCOPE_AGENT);
                    attn_run_unit(p, l, lds, u, tid);
                    __syncthreads();
                    if (tid == 0) misc[16] = nxt;
                    __syncthreads();
                    u = (int)misc[16];
                }
            }
            MK_TS(10);
            {
                unsigned* done = ctl + 4224 + 64 * l;
                if (tid == 0) { unsigned sp = 0; while (__hip_atomic_load(done, __ATOMIC_RELAXED, __HIP_MEMORY_SCOPE_AGENT) < (unsigned)(NB * 8)) { __builtin_amdgcn_s_sleep(2); if (++sp > (1u << 22)) break; }
                    __builtin_amdgcn_fence(__ATOMIC_ACQUIRE, "agent"); asm volatile("s_waitcnt vmcnt(0)" ::: "memory"); }
                __syncthreads();
                p5_gdn_combine(p, l, l == 0 ? M : NLAT, gw, ngw, lane);
            }
        } else if (sub == 6) {
            MK_TS(12);
            const int Mo = l == 0 ? M : NLAT;
            pg8::Gemm g{(const pg8::bf16_t*)(p.ws + WS_GATE), (const pg8::bf16_t*)(p.ws + WS_WOUT) + (size_t)l * 1024 * 1024, Mo, 1024, 1024};
            pg8::StaticOrder S; S.init(Mo, 1024, G, wg);
            EpiY E{(bf16*)(p.ws + WS_H), (const float*)(p.ws + WS_MOD) + (size_t)l * 17 * 3072};
            pg8::gemm_phase<EpiY, pg8::StaticOrder, false, MK_PG8_ALIGN, MK_PG8_SP2>(lds, g, S, E, nullptr, tid);
        } else {
            MK_TS(13);
            p7_final(p, gw, ngw, lane);
#ifdef MK_TSEL
            MK_TS(15);
            if (blockIdx.x == 0 && tid == 0) {
                const unsigned n = tsb[0]; unsigned long long sel = 0;
                for (unsigned k = 0; k + 1 < n; ++k) { const unsigned tag = tsb[1 + 3 * k]; const unsigned long long t0 = ((unsigned long long)tsb[3 + 3 * k] << 32) | tsb[2 + 3 * k], t1 = ((unsigned long long)tsb[6 + 3 * k] << 32) | tsb[5 + 3 * k];
                    if ((MK_TSEL >> tag) & 1u) sel += t1 - t0; }
                const unsigned long long tend = __builtin_amdgcn_s_memrealtime();
                while (__builtin_amdgcn_s_memrealtime() - tend < (unsigned long long)MK_TMUL * sel) __builtin_amdgcn_s_sleep(8);
            }
#endif
        }
        if (ph + 1 < a.ph_hi) {
            MK_TS(14);
#if MK_COOP
            if (ph == 0) cooperative_groups::this_grid().sync(); else
#endif
            xcd_barrier(bar, tid);
        }
#undef tid
#undef wave
#undef lane
#undef gw
    }
}
}

#ifndef MK_N_LAUNCHES
#define MK_N_LAUNCHES 1
#endif
extern "C" void kernel_launch(void* const* d_in, const int* in_sizes, int n_in, void* d_out, int out_size, void* d_ws, size_t ws_size, hipStream_t stream) {
    static int grid = 0;
    if (grid == 0) {
        if (n_in != 20 || ws_size < mk::WS_END) { fprintf(stderr, "kernel_launch: unexpected n_in %d / ws_size %zu\n", n_in, ws_size); grid = -1; return; }
        int dev = 0, cus = 0, per_cu = 0;
        if (hipGetDevice(&dev) != hipSuccess || hipDeviceGetAttribute(&cus, hipDeviceAttributeMultiprocessorCount, dev) != hipSuccess) { grid = -1; return; }
        if (hipFuncSetAttribute((const void*)mk::mega, hipFuncAttributeMaxDynamicSharedMemorySize, mk::LDS_BYTES) != hipSuccess) { fprintf(stderr, "kernel_launch: hipFuncSetAttribute failed\n"); grid = -1; return; }
        if (hipOccupancyMaxActiveBlocksPerMultiprocessor(&per_cu, (const void*)mk::mega, mk::NT, mk::LDS_BYTES) != hipSuccess || per_cu < 1) { fprintf(stderr, "kernel_launch: occupancy query says %d blocks per CU\n", per_cu); grid = -1; return; }
        grid = cus;
    }
    if (grid < 0) return;
    (void)hipMemsetAsync((char*)d_ws + mk::WS_CTL, 0, mk::CTL_BYTES, stream);
    mk::KArgs a{};
    const float** pp = (const float**)&a.p;
    for (int i = 0; i < 20; ++i) pp[i] = (const float*)d_in[i];
    a.p.out = (float*)d_out; a.p.ws = (unsigned char*)d_ws;
    if (MK_N_LAUNCHES == 1) {
        a.ph_lo = 0; a.ph_hi = mk::N_PHASES;
        void* args[] = {&a};
#if MK_COOP
        const hipError_t e = hipLaunchCooperativeKernel((const void*)mk::mega, dim3(grid), dim3(mk::NT), args, mk::LDS_BYTES, stream);
#else
        const hipError_t e = hipLaunchKernel((const void*)mk::mega, dim3(grid), dim3(mk::NT), args, mk::LDS_BYTES, stream);
#endif
        if (e != hipSuccess) fprintf(stderr, "kernel_launch: launch failed: %s\n", hipGetErrorString(e));
    } else {
        for (int ph = 0; ph < mk::N_PHASES; ++ph) { a.ph_lo = ph; a.ph_hi = ph + 1; hipLaunchKernelGGL(mk::mega, dim3(grid), dim3(mk::NT), mk::LDS_BYTES, stream, a); }
    }
}
```
